# Optimizing an MI355X kernel written in HIP

```python
import math
import jax, jax.numpy as jnp
from jax import lax
import numpy as np

D_MODEL = 1024
BATCH = 2
SEQ = 16384
DEPTH = 2

GRID_W = 64
CTX_LEN = 256
HEAD_DIM = 64
EPS = 1e-6
NEG_INF = -1e30

A_HEADS = D_MODEL // 256
A_WIDTH = A_HEADS * HEAD_DIM
CHUNK = 128
B_HEADS = (3 * D_MODEL) // 512
B_WIDTH = B_HEADS * HEAD_DIM
NA_ROWS = 8
NA_COLS = 16
C_HEADS = (3 * D_MODEL) // 512
C_NOPE = 64
C_ROPE = 32
C_QK = C_NOPE + C_ROPE
C_VDIM = 64
C_Q_LORA = (3 * D_MODEL) // 8
C_KV_LORA = D_MODEL // 4
C_WIDTH = C_HEADS * C_VDIM
Q_BLOCK = 128
ROPE_BASE = 10000.0

MIX_WIDTH = A_WIDTH + B_WIDTH + C_WIDTH
IN_A = 2 * A_WIDTH
IN_B = 3 * B_WIDTH
IN_C = C_Q_LORA + C_KV_LORA + C_ROPE
IN_WIDTH = IN_A + IN_B + IN_C

N_GROUPS = 8
EXPERTS_PER_GROUP = 8
N_EXPERTS = N_GROUPS * EXPERTS_PER_GROUP
TOP_K = 2
D_EXPERT = D_MODEL // 2
MOE_BLOCK = 128

kernel_name = 'hybrid_dit_gmlp_natten_mla_hmoe'


def rmsnorm(x, g):
    xf = x.astype(jnp.float32)
    y = xf * lax.rsqrt(jnp.mean(xf * xf, axis=-1, keepdims=True) + EPS)
    return (y * g.astype(jnp.float32)).astype(x.dtype)


def modulate(h, shift, scale):
    return h * (1 + scale) + shift


def rope_table(pos):
    half = C_ROPE // 2
    inv = ROPE_BASE ** (-jnp.arange(0, half, 2, dtype=jnp.float32) / half)
    ang = pos.astype(jnp.float32)[:, None] * inv[None, :]
    return jnp.cos(ang), jnp.sin(ang)


def rope_1d(x, cos, sin):
    x1, x2 = jnp.split(x, 2, axis=-1)
    return jnp.concatenate([x1 * cos - x2 * sin, x2 * cos + x1 * sin], axis=-1)


def axial_rope(x, cos_r, sin_r, cos_c, sin_c):
    half = C_ROPE // 2
    return jnp.concatenate([rope_1d(x[..., :half], cos_r, sin_r), rope_1d(x[..., half:], cos_c, sin_c)], axis=-1)


def chunk_gmlp(z, v_norm, w_s, b_s):
    bn, t, _ = z.shape
    u, v = jnp.split(jax.nn.gelu(z), 2, axis=-1)
    v = rmsnorm(v, v_norm).reshape(bn, t // CHUNK, CHUNK, A_HEADS, HEAD_DIM)
    v = jnp.einsum('hpq,bnqhd->bnphd', w_s, v) + b_s.T[:, :, None]
    return u * v.reshape(bn, t, A_WIDTH)


def heads_qkv(z, q_norm, k_norm):
    bn, t, _ = z.shape
    q, k, v = jnp.split(z, 3, axis=-1)
    q = rmsnorm(q.reshape(bn, t, B_HEADS, HEAD_DIM), q_norm)
    k = rmsnorm(k.reshape(bn, t, B_HEADS, HEAD_DIM), k_norm)
    return q, k, v.reshape(bn, t, B_HEADS, HEAD_DIM)


def dense_attend(q, k, v):
    s = jnp.einsum('bqhd,bkhd->bhqk', q, k).astype(jnp.float32) * (HEAD_DIM ** -0.5)
    p = jax.nn.softmax(s, axis=-1).astype(v.dtype)
    o = jnp.einsum('bhqk,bkhd->bqhd', p, v)
    return o.reshape(o.shape[0], o.shape[1], -1)


def neighbourhood_attention(q, k, v, k_ctx, v_ctx, rpb):
    bn, l, h, dh = q.shape
    rows = l // GRID_W
    kh = min(NA_ROWS, rows)
    r = jnp.arange(rows)
    r0 = jnp.clip(r - kh // 2, 0, rows - kh)
    key_rows = r0[:, None] + jnp.arange(kh)[None, :]
    cq = jnp.arange(GRID_W)
    c0 = jnp.clip(cq - NA_COLS // 2, 0, GRID_W - NA_COLS)
    in_win = (cq[None, :] >= c0[:, None]) & (cq[None, :] < c0[:, None] + NA_COLS)
    dc = jnp.clip(cq[None, :] - cq[:, None], -(NA_COLS - 1), NA_COLS - 1) + NA_COLS - 1
    dr = key_rows - r[:, None] + NA_ROWS - 1
    bias = jnp.take(rpb[:, dr], dc, axis=-1)
    bias = bias.transpose(0, 1, 3, 2, 4).astype(jnp.float32)
    qg = q.reshape(bn, rows, GRID_W, h, dh)
    kg = k.reshape(bn, rows, GRID_W, h, dh)[:, key_rows]
    vg = v.reshape(bn, rows, GRID_W, h, dh)[:, key_rows]
    scale = dh ** -0.5
    s_loc = jnp.einsum('brqhd,brkwhd->bhrqkw', qg, kg).astype(jnp.float32) * scale + bias[None]
    s_loc = jnp.where(in_win[:, None, :], s_loc, NEG_INF)
    s_ctx = jnp.einsum('brqhd,bchd->bhrqc', qg, k_ctx).astype(jnp.float32) * scale
    s = jnp.concatenate([s_loc.reshape(bn, h, rows, GRID_W, kh * GRID_W), s_ctx], axis=-1)
    p = jax.nn.softmax(s, axis=-1).astype(v.dtype)
    p_loc = p[..., :kh * GRID_W].reshape(bn, h, rows, GRID_W, kh, GRID_W)
    p_ctx = p[..., kh * GRID_W:]
    o = jnp.einsum('bhrqkw,brkwhd->brqhd', p_loc, vg) + jnp.einsum('bhrqc,bchd->brqhd', p_ctx, v_ctx)
    return o.reshape(bn, l, h * dh)


def mla_project(z, q_a_norm, w_q_up, kv_a_norm, w_kv_up, q_norm, k_norm):
    bn, t, _ = z.shape
    q_lat, kv_lat, k_rope = jnp.split(z, [C_Q_LORA, C_Q_LORA + C_KV_LORA], axis=-1)
    q = (rmsnorm(q_lat, q_a_norm) @ w_q_up).reshape(bn, t, C_HEADS, C_QK)
    kv = (rmsnorm(kv_lat, kv_a_norm) @ w_kv_up).reshape(bn, t, C_HEADS, C_NOPE + C_VDIM)
    k_nope, v = jnp.split(kv, [C_NOPE], axis=-1)
    q_nope = rmsnorm(q[..., :C_NOPE], q_norm[:C_NOPE])
    q_rope = rmsnorm(q[..., C_NOPE:], q_norm[C_NOPE:])
    k_nope = rmsnorm(k_nope, k_norm[:C_NOPE])
    k_rope = rmsnorm(k_rope, k_norm[C_NOPE:])
    return q_nope, q_rope, k_nope, k_rope, v


def mla_attend(q_nope, q_rope, k_nope, k_rope, v):
    s = jnp.einsum('bqhd,bkhd->bhqk', q_nope, k_nope) + jnp.einsum('bqhd,bkd->bhqk', q_rope, k_rope)
    p = jax.nn.softmax(s.astype(jnp.float32) * (C_QK ** -0.5), axis=-1).astype(v.dtype)
    o = jnp.einsum('bhqk,bkhd->bqhd', p, v)
    return o.reshape(o.shape[0], o.shape[1], -1)


def mla_latent_attention(q_nope, q_rope, k_nope, k_rope, v):
    bn, l, h, _ = q_nope.shape
    nb = l // Q_BLOCK
    qn = q_nope.reshape(bn, nb, Q_BLOCK, h, C_NOPE).transpose(1, 0, 2, 3, 4)
    qr = q_rope.reshape(bn, nb, Q_BLOCK, h, C_ROPE).transpose(1, 0, 2, 3, 4)
    o = lax.map(lambda a: mla_attend(a[0], a[1], k_nope, k_rope, v), (qn, qr))
    return o.transpose(1, 0, 2, 3).reshape(bn, l, h * C_VDIM)


def hier_moe(t, w_group, w_router, w1, w3, w2):
    n, d = t.shape
    tok = jnp.arange(n)
    g_logits = (t @ w_group).astype(jnp.float32)
    g_idx = jnp.argmax(g_logits, axis=-1)
    g_gate = jax.nn.softmax(g_logits, axis=-1)[tok, g_idx]
    e_logits = (t @ w_router).astype(jnp.float32).reshape(n, N_GROUPS, EXPERTS_PER_GROUP)[tok, g_idx]
    top_l, top_j = lax.top_k(e_logits, TOP_K)
    weights = g_gate[:, None] * jax.nn.softmax(top_l, axis=-1)
    expert = g_idx[:, None] * EXPERTS_PER_GROUP + top_j
    a = n * TOP_K
    flat_e = expert.reshape(a)
    flat_tok = jnp.arange(a) // TOP_K
    flat_w = weights.reshape(a)
    order = jnp.argsort(flat_e)
    se, stok, sw = flat_e[order], flat_tok[order], flat_w[order]
    counts = jnp.bincount(flat_e, length=N_EXPERTS)
    starts = jnp.cumsum(counts) - counts
    pcounts = (counts + MOE_BLOCK - 1) // MOE_BLOCK * MOE_BLOCK
    pends = jnp.cumsum(pcounts)
    pstarts = pends - pcounts
    dest = pstarts[se] + (jnp.arange(a) - starts[se])
    n_blocks = -(-a // MOE_BLOCK) + N_EXPERTS
    p_slots = n_blocks * MOE_BLOCK
    slot_tok = jnp.zeros((p_slots,), jnp.int32).at[dest].set(stok.astype(jnp.int32))
    slot_w = jnp.zeros((p_slots,), t.dtype).at[dest].set(sw.astype(t.dtype))
    block_e = jnp.minimum(jnp.searchsorted(pends, jnp.arange(n_blocks) * MOE_BLOCK, side='right'), N_EXPERTS - 1)
    xs = t[slot_tok].reshape(n_blocks, MOE_BLOCK, d)

    def expert_block(args):
        xb, e = args
        hb = jax.nn.silu(xb @ w1[e]) * (xb @ w3[e])
        return hb @ w2[e]

    ys = lax.map(expert_block, (xs, block_e)).reshape(p_slots, d)
    return jnp.zeros_like(t).at[slot_tok].add(ys * slot_w[:, None])


def setup_inputs(seed: int = 0) -> dict:
    key = jax.random.key(seed)
    ks = jax.random.split(key, 27)
    f32 = jnp.float32

    def nrm(i, shape, s):
        return jax.random.normal(ks[i], shape, f32) * s

    def gain(i, shape):
        return 1.0 + 0.01 * jax.random.normal(ks[i], shape, f32)

    L, D = DEPTH, D_MODEL
    return {
        'x': nrm(0, (BATCH, SEQ, D), 1.0),
        'c': nrm(1, (BATCH, D), 1.0),
        'ctx': nrm(2, (BATCH, CTX_LEN, D), 1.0),
        'c_ctx': nrm(3, (D,), 1.0),
        'w_ada': nrm(4, (L, D, 6 * D), 0.5 * D ** -0.5),
        'b_ada': nrm(5, (L, 6 * D), 0.02),
        'norm_mix': gain(6, (L, D)),
        'w_in': nrm(7, (L, D, IN_WIDTH), D ** -0.5),
        'a_v_norm': gain(8, (L, A_WIDTH)),
        'a_w_s': nrm(9, (L, A_HEADS, CHUNK, CHUNK), CHUNK ** -0.5),
        'a_b_s': 1.0 + nrm(10, (L, A_HEADS, CHUNK), 0.02),
        'b_q_norm': gain(11, (L, HEAD_DIM)),
        'b_k_norm': gain(12, (L, HEAD_DIM)),
        'b_rpb': nrm(13, (L, B_HEADS, 2 * NA_ROWS - 1, 2 * NA_COLS - 1), 0.1),
        'c_q_a_norm': gain(14, (L, C_Q_LORA)),
        'c_w_q_up': nrm(15, (L, C_Q_LORA, C_HEADS * C_QK), C_Q_LORA ** -0.5),
        'c_kv_a_norm': gain(16, (L, C_KV_LORA)),
        'c_w_kv_up': nrm(17, (L, C_KV_LORA, C_HEADS * (C_NOPE + C_VDIM)), C_KV_LORA ** -0.5),
        'c_q_norm': gain(18, (L, C_QK)),
        'c_k_norm': gain(19, (L, C_QK)),
        'w_out': nrm(20, (L, MIX_WIDTH, D), MIX_WIDTH ** -0.5),
        'norm_ffn': gain(21, (L, D)),
        'moe_w_group': nrm(22, (L, D, N_GROUPS), D ** -0.5),
        'moe_w_router': nrm(23, (L, D, N_EXPERTS), D ** -0.5),
        'moe_w1': nrm(24, (L, N_EXPERTS, D, D_EXPERT), D ** -0.5),
        'moe_w3': nrm(25, (L, N_EXPERTS, D, D_EXPERT), D ** -0.5),
        'moe_w2': nrm(26, (L, N_EXPERTS, D_EXPERT, D), D_EXPERT ** -0.5),
    }


def reference(x, c, ctx, c_ctx, w_ada, b_ada, norm_mix, w_in, a_v_norm, a_w_s, a_b_s, b_q_norm, b_k_norm, b_rpb,
              c_q_a_norm, c_w_q_up, c_kv_a_norm, c_w_kv_up, c_q_norm, c_k_norm, w_out, norm_ffn,
              moe_w_group, moe_w_router, moe_w1, moe_w3, moe_w2):
    bn, l, d = x.shape
    nc = ctx.shape[1]
    pos = jnp.arange(l)
    cos_r, sin_r = rope_table(pos // GRID_W)
    cos_c, sin_c = rope_table(pos % GRID_W)
    cos_r, sin_r, cos_c, sin_c = (a.astype(x.dtype) for a in (cos_r, sin_r, cos_c, sin_c))
    silu_c = jax.nn.silu(c)
    silu_cc = jax.nn.silu(c_ctx)
    xc = ctx
    for i in range(DEPTH):
        need_ctx = i < DEPTH - 1
        mod = silu_c @ w_ada[i] + b_ada[i]
        mod_c = silu_cc @ w_ada[i] + b_ada[i]
        sh1, s1, g1, sh2, s2, g2 = [m[:, None, :] for m in jnp.split(mod, 6, axis=-1)]
        sh1c, s1c, g1c, sh2c, s2c, g2c = jnp.split(mod_c, 6, axis=-1)

        h = modulate(rmsnorm(x, norm_mix[i]), sh1, s1)
        hc = modulate(rmsnorm(xc, norm_mix[i]), sh1c, s1c)
        z_a, z_b, z_c = jnp.split(h @ w_in[i], [IN_A, IN_A + IN_B], axis=-1)
        zc_a, zc_b, zc_c = jnp.split(hc @ w_in[i], [IN_A, IN_A + IN_B], axis=-1)
        o_a = chunk_gmlp(z_a, a_v_norm[i], a_w_s[i], a_b_s[i])
        q_b, k_b, v_b = heads_qkv(z_b, b_q_norm[i], b_k_norm[i])
        qc_b, kc_b, vc_b = heads_qkv(zc_b, b_q_norm[i], b_k_norm[i])
        o_b = neighbourhood_attention(q_b, k_b, v_b, kc_b, vc_b, b_rpb[i])
        qn, qr, kn, kr, v_c = mla_project(z_c, c_q_a_norm[i], c_w_q_up[i], c_kv_a_norm[i], c_w_kv_up[i], c_q_norm[i], c_k_norm[i])
        qr = axial_rope(qr, cos_r[:, None], sin_r[:, None], cos_c[:, None], sin_c[:, None])
        kr = axial_rope(kr, cos_r, sin_r, cos_c, sin_c)
        cqn, cqr, ckn, ckr, cv = mla_project(zc_c, c_q_a_norm[i], c_w_q_up[i], c_kv_a_norm[i], c_w_kv_up[i], c_q_norm[i], c_k_norm[i])
        o_c = mla_latent_attention(qn, qr, jnp.concatenate([kn, ckn], axis=1), jnp.concatenate([kr, ckr], axis=1),
                                   jnp.concatenate([v_c, cv], axis=1))
        x = x + g1 * (jnp.concatenate([o_a, o_b, o_c], axis=-1) @ w_out[i])
        if need_ctx:
            oc_a = chunk_gmlp(zc_a, a_v_norm[i], a_w_s[i], a_b_s[i])
            oc_b = dense_attend(qc_b, kc_b, vc_b)
            oc_c = mla_attend(cqn, cqr, ckn, ckr, cv)
            xc = xc + g1c * (jnp.concatenate([oc_a, oc_b, oc_c], axis=-1) @ w_out[i])

        h2 = modulate(rmsnorm(x, norm_ffn[i]), sh2, s2).reshape(bn * l, d)
        if need_ctx:
            h2c = modulate(rmsnorm(xc, norm_ffn[i]), sh2c, s2c).reshape(bn * nc, d)
            y = hier_moe(jnp.concatenate([h2, h2c], axis=0), moe_w_group[i], moe_w_router[i], moe_w1[i], moe_w3[i], moe_w2[i])
            x = x + g2 * y[:bn * l].reshape(bn, l, d)
            xc = xc + g2c * y[bn * l:].reshape(bn, nc, d)
        else:
            y = hier_moe(h2, moe_w_group[i], moe_w_router[i], moe_w1[i], moe_w3[i], moe_w2[i])
            x = x + g2 * y.reshape(bn, l, d)
    return x
```

```cpp
#include <hip/hip_runtime.h>
#include <stdint.h>
#include <stdio.h>

#ifndef N_LAUNCH_MODE
#define N_LAUNCH_MODE 1
#endif

typedef unsigned short bf16_t;
typedef short bf16x8 __attribute__((ext_vector_type(8)));
typedef short v4i16_t __attribute__((ext_vector_type(4)));
typedef float f32x16 __attribute__((ext_vector_type(16)));
typedef _Float16 f16x8 __attribute__((ext_vector_type(8)));
typedef int v8i __attribute__((ext_vector_type(8)));
typedef int i32x4 __attribute__((ext_vector_type(4)));
typedef _Float16 f16x2 __attribute__((ext_vector_type(2)));
typedef float f32x4 __attribute__((ext_vector_type(4)));
typedef float f32x2 __attribute__((ext_vector_type(2)));
typedef __bf16 bf16v2 __attribute__((ext_vector_type(2)));
typedef unsigned u32x4 __attribute__((ext_vector_type(4)));
typedef unsigned u32x2 __attribute__((ext_vector_type(2)));
#ifndef DBL_PH
#define DBL_PH -1
#endif
#ifndef PROBE_MODE
#define PROBE_MODE 0
#endif
#define REP(x) for (int rep_ = 0; rep_ < ((DBL_PH) == (x) ? 2 : 1); ++rep_)
#define LAS __attribute__((address_space(3)))
#define DEV __device__ __forceinline__
#define MFMA(a, b, c) __builtin_amdgcn_mfma_f32_32x32x16_bf16((a), (b), (c), 0, 0, 0)
#define WAITV(n) asm volatile("s_waitcnt vmcnt(%0)" ::"n"(n) : "memory")
#define SBAR() do { asm volatile("s_waitcnt lgkmcnt(0)" ::: "memory"); __builtin_amdgcn_s_barrier(); asm volatile("" ::: "memory"); } while (0)

constexpr int DM = 1024, NLAT = 32768, NCTX = 512, NTOK = 33280, SEQ = 16384, CTXL = 256;
constexpr int INW = 2336, INWP = 2432;
constexpr float EPS = 1e-6f, LOG2E = 1.4426950408889634f;
constexpr int NTHREADS = 512;
constexpr int HLD = 2048 + 64;
constexpr int MOE_CAP = 33280;
constexpr int MOE_RB = 256;
constexpr int MOE_MAXROWS = (NTOK * 2 / MOE_RB + 64) * MOE_RB;

constexpr size_t al256(size_t x) { return (x + 255) & ~(size_t)255; }
constexpr size_t WS_CTL = 0;
constexpr size_t WS_MOD = 65536;
constexpr size_t WS_ROPE = WS_MOD + al256(2 * 3 * 6144 * 4);
constexpr size_t WS_SCAL = WS_ROPE + 16384;
constexpr size_t WS_WIN = WS_SCAL + 256;
constexpr size_t WS_WQ = WS_WIN + (size_t)2 * INWP * 1024 * 2;
constexpr size_t WS_WKV = WS_WQ + (size_t)2 * 576 * 384 * 2;
constexpr size_t WS_WOUT = WS_WKV + (size_t)2 * 768 * 256 * 2;
constexpr size_t WS_WOUTP = WS_WOUT + (size_t)2 * 1024 * 1024 * 2;
constexpr size_t WS_WRT = WS_WOUTP + (size_t)2 * 1024 * 1024 * 2;
constexpr size_t WS_WSP = WS_WRT + (size_t)2 * 128 * 3072 * 2;
constexpr size_t WS_W13 = WS_WSP + (size_t)2 * 4 * 128 * 128 * 2;
constexpr size_t WS_W2 = WS_W13 + (size_t)2 * 64 * 1024 * 1024 * 2;
constexpr size_t WS_X = WS_W2 + (size_t)2 * 64 * 1024 * 512 * 2;
constexpr size_t WS_H = WS_X + (size_t)NTOK * 1024 * 4;
constexpr size_t WS_OVL = WS_H + (size_t)NTOK * HLD * 2;
constexpr size_t WS_ZA = WS_OVL;
constexpr size_t WS_ZC = WS_ZA + (size_t)NTOK * 512 * 2;
constexpr size_t WS_QB = WS_ZC + (size_t)NTOK * 640 * 2;
constexpr size_t WS_KVB = WS_QB + (size_t)NTOK * 384 * 2;
constexpr size_t WS_KR = WS_KVB + (size_t)2 * 6 * 260 * 16384;
constexpr size_t WS_SS = WS_KR + (size_t)NTOK * 32 * 2;
constexpr size_t WS_QC = WS_SS + (size_t)NTOK * 16 * 4;
constexpr size_t WS_KVC = WS_QC + (size_t)NTOK * 576 * 2;
constexpr size_t WS_MIX = WS_KVC + (size_t)2 * 6 * 130 * 40960;
constexpr size_t WS_MIXEND = WS_MIX + (size_t)NTOK * 1024 * 2;
constexpr size_t WS_LG = WS_OVL;
constexpr size_t WS_LIST = WS_LG + (size_t)NTOK * 128 * 4;
constexpr size_t WS_TIE = WS_LIST + (size_t)64 * MOE_CAP * 4;
constexpr size_t WS_HB = WS_TIE + (size_t)NTOK * 16;
constexpr size_t WS_YS = WS_HB + (size_t)MOE_MAXROWS * 512 * 2;
constexpr size_t WS_MOEEND = WS_YS + (size_t)MOE_MAXROWS * 1024 * 2;
constexpr size_t WS_END = (WS_MIXEND > WS_MOEEND ? WS_MIXEND : WS_MOEEND);

constexpr int MLA_KSUB = 8192, MLA_VOFF = 2 * MLA_KSUB, MLA_VSUB = 4096, MLA_IMG = MLA_VOFF + 2 * MLA_VSUB;
constexpr int CW_XRANK = 9216;
constexpr int CW_CNT = 4096;

constexpr int LDS_MAIN = 147456;
constexpr int LDS_BYTES = LDS_MAIN + 256;

struct Params {
    const float *x, *c, *ctx, *c_ctx, *w_ada, *b_ada, *norm_mix, *w_in, *a_v_norm, *a_w_s, *a_b_s, *b_q_norm, *b_k_norm, *b_rpb,
        *c_q_a_norm, *c_w_q_up, *c_kv_a_norm, *c_w_kv_up, *c_q_norm, *c_k_norm, *w_out, *norm_ffn, *moe_w_group, *moe_w_router,
        *moe_w1, *moe_w3, *moe_w2;
    float* out;
    unsigned char* ws;
    int ph_lo, ph_hi;
};

DEV int otid() { int t = threadIdx.x; asm volatile("" : "+v"(t)); return t; }
struct Params;
DEV unsigned char* ows_(unsigned char* w) { asm volatile("" : "+s"(w)); return w; }
DEV unsigned cvtpk(float lo, float hi) { f32x2 v = {lo, hi}; bf16v2 r = __builtin_convertvector(v, bf16v2); return __builtin_bit_cast(unsigned, r); }
DEV unsigned cvtpk_h(float lo, float hi) { f32x2 v = {lo, hi}; f16x2 r = __builtin_convertvector(v, f16x2); return __builtin_bit_cast(unsigned, r); }
DEV unsigned pk_fp8x4(float a, float b, float c, float d) { int w = __builtin_amdgcn_cvt_pk_fp8_f32(a, b, 0, false); w = __builtin_amdgcn_cvt_pk_fp8_f32(c, d, w, true); return (unsigned)w; }
DEV u32x4 pk_fp8x16(const f32x16& v) { return (u32x4){pk_fp8x4(v[0], v[1], v[2], v[3]), pk_fp8x4(v[4], v[5], v[6], v[7]), pk_fp8x4(v[8], v[9], v[10], v[11]), pk_fp8x4(v[12], v[13], v[14], v[15])}; }
DEV float bflo(unsigned u) { return __uint_as_float(u << 16); }
DEV float bfhi(unsigned u) { return __uint_as_float(u & 0xffff0000u); }
DEV float bf2f(bf16_t b) { return __uint_as_float(((unsigned)b) << 16); }
DEV int crow(int i, int h) { return (i & 3) + 8 * (i >> 2) + 4 * h; }
DEV int perm32(int rho) { return 16 * ((rho >> 2) & 1) + 4 * (rho >> 3) + (rho & 3); }
DEV float fast_rcp(float x) { return __builtin_amdgcn_rcpf(x); }
DEV float fast_rsq(float x) { return __builtin_amdgcn_rsqf(x); }
DEV float ex2(float x) { return __builtin_amdgcn_exp2f(x); }
DEV float gelu_tanh(float x) { const float u2 = x * (1.5957691216057308f + 0.07135481627f * x * x); return x * fast_rcp(1.0f + ex2(-u2 * LOG2E)); }
DEV float silu_f(float a) { return a * fast_rcp(1.0f + ex2(-a * LOG2E)); }
template <int CTRL> DEV float dpp_mov(float v) { return __builtin_bit_cast(float, __builtin_amdgcn_update_dpp(0, __builtin_bit_cast(int, v), CTRL, 0xf, 0xf, true)); }
DEV float lx1(float v) { return dpp_mov<0xB1>(v); }
DEV float lx2(float v) { return dpp_mov<0x4E>(v); }
DEV float lr4(float v) { return dpp_mov<0x124>(v); }
DEV float lr8(float v) { return dpp_mov<0x128>(v); }
DEV float lx16(float v) { return __builtin_bit_cast(float, __builtin_amdgcn_ds_swizzle(__builtin_bit_cast(int, v), 0x401F)); }
DEV void swap32(float v, float& a, float& b) { a = v; b = v; asm volatile("s_nop 1\n\tv_permlane32_swap_b32 %0, %1\n\ts_nop 1" : "+v"(a), "+v"(b)); }
DEV u32x4 zero_u32x4() { unsigned z = 0u; asm volatile("" : "+v"(z)); return (u32x4){z, z, z, z}; }
DEV float half_sum(float v) { float a, b; swap32(v, a, b); return a + b; }
DEV float wave_sum(float v) { v = half_sum(v); v += lx16(v); v += lr8(v); v += lr4(v); v += lx2(v); v += lx1(v); return v; }
DEV float wave_max(float v) { float a, b; swap32(v, a, b); v = fmaxf(a, b); v = fmaxf(v, lx16(v)); v = fmaxf(v, lr8(v)); v = fmaxf(v, lr4(v)); v = fmaxf(v, lx2(v)); v = fmaxf(v, lx1(v)); return v; }
DEV void glds16(const void* g, LAS char* l) { __builtin_amdgcn_global_load_lds((const unsigned*)g, (LAS unsigned*)l, 16, 0, 0); }
DEV void glds16s(const void* sbase, unsigned voff, unsigned lds_base) { unsigned sv; asm volatile("s_mov_b32 %0, m0\n\ts_mov_b32 m0, %3\n\ts_nop 0\n\tglobal_load_lds_dwordx4 %1, %2\n\ts_mov_b32 m0, %0" : "=&s"(sv) : "v"(voff), "s"(sbase), "s"(lds_base) : "memory"); }
DEV void glds16a(const void* g, unsigned lds_base) { unsigned sv; asm volatile("s_mov_b32 %0, m0\n\ts_mov_b32 m0, %2\n\ts_nop 0\n\tglobal_load_lds_dwordx4 %1, off\n\ts_mov_b32 m0, %0" : "=&s"(sv) : "v"(g), "s"(lds_base) : "memory"); }
DEV unsigned lds_addr(LAS char* p) { return (unsigned)(uintptr_t)p; }
DEV bf16x8 lds_b128(LAS char* p) { return *(LAS bf16x8*)p; }
DEV v4i16_t lds_tr(LAS char* p) { return __builtin_amdgcn_ds_read_tr16_b64_v4i16((LAS v4i16_t*)p); }
DEV bf16x8 cat4(v4i16_t a, v4i16_t b) { return __builtin_shufflevector(a, b, 0, 1, 2, 3, 4, 5, 6, 7); }
DEV void tok_info(int tok, int& b, int& kidx) { if (tok < NLAT) { b = tok >> 14; kidx = tok & 16383; } else { const int j = tok - NLAT; b = j >> 8; kidx = 16384 + (j & 255); } }
DEV int mod_row(int tok) { return tok < NLAT ? (tok >> 14) : 2; }
DEV void pack16(const f32x16& v, u32x4& lo, u32x4& hi) {
    lo = (u32x4){cvtpk(v[0], v[1]), cvtpk(v[2], v[3]), cvtpk(v[4], v[5]), cvtpk(v[6], v[7])};
    hi = (u32x4){cvtpk(v[8], v[9]), cvtpk(v[10], v[11]), cvtpk(v[12], v[13]), cvtpk(v[14], v[15])};
}
DEV float sumsq16(const f32x16& v) { float s = 0.f;
#pragma unroll
    for (int i = 0; i < 16; ++i) s += v[i] * v[i];
    return s; }

#define XB_TMO      128
#define XB_XCNT(j)  (256  + 64 * (j))
#define XB_XSUB(j)  (1280 + 64 * (j))
#define XB_XGEN(j)  (2304 + 64 * (j))
#define XB_TOP      3328
#define XB_TOPGEN   3392
#define XCD_BAR_WORDS 3456
#define XB_SPIN_CAP (1u << 22)
DEV unsigned xb_ld(unsigned* p)              { return __hip_atomic_load(p, __ATOMIC_RELAXED, __HIP_MEMORY_SCOPE_AGENT); }
DEV unsigned xb_add(unsigned* p, unsigned v) { return __hip_atomic_fetch_add(p, v, __ATOMIC_RELAXED, __HIP_MEMORY_SCOPE_AGENT); }
DEV unsigned xb_xcc_id() { return (unsigned)__builtin_amdgcn_s_getreg((3 << 11) | 20) & 0xFu; }
#define XB_SPIN(cond, bar) do { unsigned _sp = 0; while (cond) { __builtin_amdgcn_s_sleep(1); \
    if ((++_sp & 255u) == 0u) { if (xb_ld(&(bar)[XB_TMO])) break; if (_sp > XB_SPIN_CAP) { atomicAdd(&(bar)[XB_TMO], 1u); break; } } } } while (0)
struct XcdBarrier { unsigned* bar; unsigned x; volatile LAS unsigned* st; };
DEV XcdBarrier xcd_barrier_post(unsigned* bar, volatile LAS unsigned* st) {
    XcdBarrier b; b.bar = bar; b.x = xb_xcc_id(); b.st = st;
    if (threadIdx.x == 0) (void)xb_add(&bar[XB_XCNT(b.x)], 1u);
    return b;
}
DEV void xcd_barrier_complete(unsigned* bar, unsigned x, unsigned& nloc, unsigned& nx) {
    const unsigned G = gridDim.x * gridDim.y * gridDim.z;
    unsigned sum, cnt, mine, sp = 0u;
    for (;;) {
        sum = 0u; cnt = 0u; mine = 0u;
#pragma unroll
        for (unsigned j = 0; j < 16; ++j) { const unsigned c = xb_ld(&bar[XB_XCNT(j)]); sum += c; cnt += (c > 0u) ? 1u : 0u; mine = (j == x) ? c : mine; }
        if (sum == G) break;
        __builtin_amdgcn_s_sleep(1);
        if ((++sp & 255u) == 0u) { if (xb_ld(&bar[XB_TMO])) break; if (sp > XB_SPIN_CAP) { atomicAdd(&bar[XB_TMO], 1u); break; } }
    }
    nloc = mine > 0u ? mine : 1u; nx = cnt > 0u ? cnt : 1u;
}
DEV void xcd_barrier(const XcdBarrier& b) {
    asm volatile("s_waitcnt vmcnt(0)" ::: "memory");
    __syncthreads();
    if (threadIdx.x == 0) {
        unsigned* bar = b.bar;
        __builtin_amdgcn_s_waitcnt(0);
        unsigned nloc = b.st[0], nx = b.st[1];
        if (nloc == 0u) { xcd_barrier_complete(bar, b.x, nloc, nx); b.st[0] = nloc; b.st[1] = nx; }
        const unsigned old = xb_add(&bar[XB_XSUB(b.x)], 1u);
        const unsigned gen = old / nloc;
        if (old + 1u == (gen + 1u) * nloc) {
            __builtin_amdgcn_fence(__ATOMIC_RELEASE, "agent");
            asm volatile("s_waitcnt vmcnt(0)" ::: "memory");
            const unsigned og = xb_add(&bar[XB_TOP], 1u);
            const unsigned tg = og / nx;
            if (og + 1u == (tg + 1u) * nx) xb_add(&bar[XB_TOPGEN], 1u);
            else XB_SPIN(xb_ld(&bar[XB_TOPGEN]) == tg, bar);
            __builtin_amdgcn_fence(__ATOMIC_ACQUIRE, "agent");
            xb_add(&bar[XB_XGEN(b.x)], 1u);
            asm volatile("s_waitcnt vmcnt(0)" ::: "memory");
        } else {
            XB_SPIN(xb_ld(&bar[XB_XGEN(b.x)]) == gen, bar);
            __builtin_amdgcn_fence(__ATOMIC_ACQUIRE, "agent");
            asm volatile("s_waitcnt vmcnt(0)" ::: "memory");
        }
    }
    __syncthreads();
}

DEV bool xorder(int U, int i, int& L, int vb) {
    const int G = gridDim.x;
    if (G & 7) { L = vb + G * i; return L < U; }
    const int per = G >> 3, chunk = (U + 7) >> 3, j = (vb % per) + per * i;
    if (j >= chunk) return false;
    L = (vb / per) * chunk + j; return L < U;
}
DEV void tile_of(int L, int nM, int nN, int& mt, int& nt) { const int g = L / (8 * nN), rem = L - g * 8 * nN, gsz = min(8, nM - 8 * g); mt = 8 * g + rem % gsz; nt = rem / gsz; }

struct Ring { int st, primed; };
template <int BM, int BN, int WM, int WN, int NST, class Epi, bool F16 = false, int SWAPWN = -1>
DEV void gemm_unit(const bf16_t* __restrict__ A, int lda, const int* __restrict__ rowidx, int nvalid, int m0, int a_wrap,
                   const bf16_t* __restrict__ Bt, int ldb, int n0, int nk, LAS char* lds, const Epi& epi, Ring* ring = nullptr, bool has_next = false, int m0n = 0, int n0n = 0) {
    constexpr int TM = BM / (WM * 32), TN = BN / (WN * 32);
    constexpr int AB = BM * 128, BB = BN * 128, STG = AB + BB, NLA = AB / 8192, NLB = BB / 8192, NL = NLA + NLB;
    static_assert(STG * NST <= LDS_MAIN, "LDS");
    const int tid = otid(), lane = tid & 63, wid = tid >> 6, r = lane & 31, h = lane >> 5;
    const int wm = wid / WN, wn = wid % WN;
    const bool swapped = SWAPWN >= 0 && __builtin_amdgcn_readfirstlane(wn) == SWAPWN;
    const int lrow = tid >> 3, lc = (tid & 7) ^ ((lrow >> 1) & 7);
    unsigned aoff[NLA], boff[NLB];
#pragma unroll
    for (int i = 0; i < NLA; ++i) { const int row = i * 64 + lrow; int grow;
        if (rowidx) grow = rowidx[row < nvalid ? row : 0]; else grow = m0 + row;
        aoff[i] = (unsigned)grow * (unsigned)lda + lc * 8; }
#pragma unroll
    for (int i = 0; i < NLB; ++i) boff[i] = (unsigned)(n0 + i * 64 + lrow) * (unsigned)ldb + lc * 8;
    unsigned aoffn[NLA], boffn[NLB];
    if (ring) {
#pragma unroll
        for (int i = 0; i < NLA; ++i) aoffn[i] = (unsigned)(m0n + i * 64 + lrow) * (unsigned)lda + lc * 8;
#pragma unroll
        for (int i = 0; i < NLB; ++i) boffn[i] = (unsigned)(n0n + i * 64 + lrow) * (unsigned)ldb + lc * 8; }
    const int sw = (r >> 1) & 7;
    unsigned koff[4];
#pragma unroll
    for (int ks = 0; ks < 4; ++ks) koff[ks] = (unsigned)(((2 * ks + h) ^ sw) << 4);
    const unsigned arow = (unsigned)(wm * TM * 32 + r) * 128u, brow = (unsigned)AB + (unsigned)(wn * TN * 32 + r) * 128u;
    f32x16 acc[TM][TN];
#pragma unroll
    for (int a = 0; a < TM; ++a)
#pragma unroll
        for (int b = 0; b < TN; ++b)
#pragma unroll
            for (int i = 0; i < 16; ++i) acc[a][b][i] = 0.f;
#define GEMM_ISSUE(kt_, st_) do { int ka_ = (kt_) * 64; if (ka_ >= a_wrap) ka_ -= a_wrap; LAS char* sa_ = lds + (st_) * STG + tid * 16; \
    _Pragma("unroll") for (int i_ = 0; i_ < NLA; ++i_) glds16(A + aoff[i_] + ka_, sa_ + i_ * 8192); \
    _Pragma("unroll") for (int i_ = 0; i_ < NLB; ++i_) glds16(Bt + boff[i_] + (kt_) * 64, sa_ + AB + i_ * 8192); } while (0)
#define GEMM_ISSUE_N(kt_, st_) do { LAS char* sa_ = lds + (st_) * STG + tid * 16; \
    _Pragma("unroll") for (int i_ = 0; i_ < NLA; ++i_) glds16(A + aoffn[i_] + (kt_) * 64, sa_ + i_ * 8192); \
    _Pragma("unroll") for (int i_ = 0; i_ < NLB; ++i_) glds16(Bt + boffn[i_] + (kt_) * 64, sa_ + AB + i_ * 8192); } while (0)
    int st = ring ? ring->st : 0;
    if (!(ring && ring->primed)) { GEMM_ISSUE(0, st); if (NST == 3 && nk > 1) GEMM_ISSUE(1, (st + 1 == NST) ? 0 : st + 1); }
    int stn = st + NST - 1; if (stn >= NST) stn -= NST;
    const bool stream_next = ring && has_next;
    for (int kt = 0; kt < nk; ++kt) {
        if (NST == 3 && (kt + 1 < nk || stream_next)) WAITV(NL); else WAITV(0);
        SBAR();
        if (kt + NST - 1 < nk) GEMM_ISSUE(kt + NST - 1, stn); else if (stream_next) GEMM_ISSUE_N(kt + NST - 1 - nk, stn);
        LAS char* sb = lds + st * STG;
        if (SWAPWN >= 0 && swapped) {
#pragma unroll
        for (int ks = 0; ks < 4; ++ks) {
            bf16x8 af[TM], wf[TN];
#pragma unroll
            for (int a = 0; a < TM; ++a) af[a] = lds_b128(sb + arow + a * 4096 + koff[ks]);
#pragma unroll
            for (int b = 0; b < TN; ++b) wf[b] = lds_b128(sb + brow + b * 4096 + koff[ks]);
#pragma unroll
            for (int a = 0; a < TM; ++a)
#pragma unroll
                for (int b = 0; b < TN; ++b) acc[a][b] = MFMA(af[a], wf[b], acc[a][b]);
        } } else {
#pragma unroll
        for (int ks = 0; ks < 4; ++ks) {
            bf16x8 af[TM], wf[TN];
#pragma unroll
            for (int a = 0; a < TM; ++a) af[a] = lds_b128(sb + arow + a * 4096 + koff[ks]);
#pragma unroll
            for (int b = 0; b < TN; ++b) wf[b] = lds_b128(sb + brow + b * 4096 + koff[ks]);
#pragma unroll
            for (int a = 0; a < TM; ++a)
#pragma unroll
                for (int b = 0; b < TN; ++b) acc[a][b] = F16 ? __builtin_amdgcn_mfma_f32_32x32x16_f16(__builtin_bit_cast(f16x8, wf[b]), __builtin_bit_cast(f16x8, af[a]), acc[a][b], 0, 0, 0)
                                                            : MFMA(wf[b], af[a], acc[a][b]);
        } }
        st = (st + 1 == NST) ? 0 : st + 1; stn = (stn + 1 == NST) ? 0 : stn + 1;
    }
#undef GEMM_ISSUE
#undef GEMM_ISSUE_N
    if (ring) { ring->st = st; ring->primed = stream_next ? 1 : 0; }
    SBAR();
    epi.template run<TM, TN>(acc, m0 + wm * TM * 32, n0 + wn * TN * 32, r, h);
}

template <class Epi, int MODE = 0>
DEV void gemm256(const bf16_t* __restrict__ A, int lda, const int* __restrict__ rowidx, int nvalid, int m0, int a_wrap,
                 const bf16_t* __restrict__ Bt, int ldb, int n0, int nk, LAS char* lds, const Epi& epi) {
    constexpr int TM = 2, TN = 4, SLOT = 32768;
    const int tid = otid(), lane = tid & 63, wid = tid >> 6, r = lane & 31, h = lane >> 5;
    const int wm = wid & 3, wn = wid >> 2;
    const int lrow = tid >> 2, lc = (tid & 3) ^ ((lrow >> 2) & 3);
    unsigned aoff[2], boff[2];
#pragma unroll
    for (int i = 0; i < 2; ++i) { const int row = i * 128 + lrow; int grow;
        if (rowidx) grow = rowidx[row < nvalid ? row : 0]; else grow = m0 + row;
        aoff[i] = (unsigned)grow * (unsigned)lda + lc * 8; boff[i] = (unsigned)(n0 + row) * (unsigned)ldb + lc * 8; }
    const int swz = (r >> 2) & 3;
    const unsigned koff0 = (unsigned)((h ^ swz) << 4), koff1 = (unsigned)(((2 + h) ^ swz) << 4);
    const unsigned arow = (unsigned)(wm * 64 + r) * 64u, brow = 16384u + (unsigned)(wn * 128 + r) * 64u;
    f32x16 acc[TM][TN];
#pragma unroll
    for (int a = 0; a < TM; ++a)
#pragma unroll
        for (int b = 0; b < TN; ++b)
#pragma unroll
            for (int i = 0; i < 16; ++i) acc[a][b][i] = 0.f;
    const int nq = 2 * nk;
#define G2_ISSUE(q_) do { int ka_ = (q_) * 32; if (ka_ >= a_wrap) ka_ -= a_wrap; LAS char* s_ = lds + ((q_) & 3) * SLOT + tid * 16; \
    glds16(A + aoff[0] + ka_, s_); glds16(A + aoff[1] + ka_, s_ + 8192); glds16(Bt + boff[0] + (q_) * 32, s_ + 16384); glds16(Bt + boff[1] + (q_) * 32, s_ + 24576); } while (0)
    if (MODE != 2) { G2_ISSUE(0); G2_ISSUE(1); G2_ISSUE(2); }
    WAITV(8); SBAR();
    if (wn == 1) SBAR();
#define G2_PIECE(q_, i_) do { int ka_ = (q_) * 32; if (ka_ >= a_wrap) ka_ -= a_wrap; LAS char* s_ = lds + ((q_) & 3) * SLOT + tid * 16; \
    if ((i_) == 0) glds16(A + aoff[0] + ka_, s_); else if ((i_) == 1) glds16(A + aoff[1] + ka_, s_ + 8192); \
    else if ((i_) == 2) glds16(Bt + boff[0] + (q_) * 32, s_ + 16384); else glds16(Bt + boff[1] + (q_) * 32, s_ + 24576); } while (0)
    for (int q = 0; q < nq; ++q) {
        LAS char* sb = lds + (q & 3) * SLOT;
        bf16x8 af[2][TM], wf[2][TN];
        if (MODE != 3) {
#pragma unroll
        for (int a = 0; a < TM; ++a) { af[0][a] = lds_b128(sb + arow + a * 2048 + koff0); af[1][a] = lds_b128(sb + arow + a * 2048 + koff1); }
#pragma unroll
        for (int b = 0; b < TN; ++b) { wf[0][b] = lds_b128(sb + brow + b * 2048 + koff0); wf[1][b] = lds_b128(sb + brow + b * 2048 + koff1); }
        }
        if (q + 2 < nq) WAITV(4); else WAITV(0);
        SBAR();
        __builtin_amdgcn_sched_barrier(0);
        __builtin_amdgcn_s_setprio(1);
        const bool pre = (MODE != 2) && (q + 3 < nq);
#pragma unroll
        for (int ks = 0; ks < 2; ++ks)
#pragma unroll
            for (int a = 0; a < TM; ++a) {
#pragma unroll
                for (int b = 0; b < TN; ++b) if (MODE != 3) acc[a][b] = MFMA(wf[ks][b], af[ks][a], acc[a][b]);
                if (pre) G2_PIECE(q + 3, ks * 2 + a);
                __builtin_amdgcn_sched_barrier(0);
            }
        __builtin_amdgcn_s_setprio(0);
        __builtin_amdgcn_sched_barrier(0);
        SBAR();
    }
#undef G2_PIECE
#undef G2_ISSUE
    if (wn == 0) SBAR();
    if (MODE == 0) epi.template run<TM, TN>(acc, m0 + wm * 64, n0 + wn * 128, r, h);
    else if (acc[0][0][0] == 12345.678f) epi.template run<TM, TN>(acc, m0 + wm * 64, n0 + wn * 128, r, h);
}

struct EpiIn {
    const Params* p; int layer;
    template <int TM, int TN> DEV void run(const f32x16 (&accf)[TM][TN], int mw, int cbw, int r, int h) const {
        static_assert(TN % 2 == 0, "64-column groups");
        unsigned char* ws = p->ws;
#pragma unroll
        for (int g2 = 0; g2 < TN / 2; ++g2)
#pragma unroll
        for (int tm = 0; tm < TM; ++tm) { const int cb = cbw + 64 * g2; const f32x16 (&acc)[TM][TN] = accf; const int T0 = 2 * g2;
            const int tok = mw + tm * 32 + r; int b, kidx; tok_info(tok, b, kidx);
            if (cb < 512) {
                bf16_t* dst = (bf16_t*)(ws + WS_ZA) + (size_t)tok * 512 + cb + 16 * h;
#pragma unroll
                for (int tn = 0; tn < 2; ++tn) { f32x16 v = acc[tm][T0 + tn];
#pragma unroll
                    for (int i = 0; i < 16; ++i) v[i] = gelu_tanh(v[i]);
                    u32x4 lo, hi; pack16(v, lo, hi); *(u32x4*)(dst + tn * 32) = lo; *(u32x4*)(dst + tn * 32 + 8) = hi; }
            } else if (cb < 1664) {
                const int sect = (cb - 512) / 384, hd = ((cb - 512) % 384) >> 6;
                if (sect == 2) {
                    unsigned char* img = ws + WS_KVB + ((size_t)((b * 6 + hd) * 260 + (kidx >> 6))) * 16384 + 8192 + (kidx & 63) * 64;
#pragma unroll
                    for (int tn = 0; tn < 2; ++tn)
#pragma unroll
                        for (int g = 0; g < 4; ++g) { u32x2 w = {cvtpk(acc[tm][T0 + tn][4 * g], acc[tm][T0 + tn][4 * g + 1]), cvtpk(acc[tm][T0 + tn][4 * g + 2], acc[tm][T0 + tn][4 * g + 3])};
                            *(u32x2*)(img + tn * 4096 + (8 * g + 4 * h) * 2) = w; }
                } else {
                    float ss = half_sum(sumsq16(acc[tm][T0]) + sumsq16(acc[tm][T0 + 1]));
                    const float rinv = fast_rsq(ss * (1.0f / 64.0f) + EPS);
                    const float* gain = (sect == 0 ? p->b_q_norm : p->b_k_norm) + layer * 64;
                    const float sc = rinv * (sect == 0 ? 0.125f * LOG2E : 1.0f);
#pragma unroll
                    for (int tn = 0; tn < 2; ++tn) { f32x16 v;
                        const f32x4* gp = (const f32x4*)(gain + tn * 32 + 16 * h);
#pragma unroll
                        for (int q = 0; q < 4; ++q) { const f32x4 g4 = gp[q];
#pragma unroll
                            for (int j = 0; j < 4; ++j) v[4 * q + j] = acc[tm][T0 + tn][4 * q + j] * sc * g4[j]; }
                        u32x4 lo, hi; pack16(v, lo, hi);
                        if (sect == 0) { bf16_t* dst = (bf16_t*)(ws + WS_QB) + (size_t)tok * 384 + hd * 64 + tn * 32 + 16 * h; *(u32x4*)dst = lo; *(u32x4*)(dst + 8) = hi; }
                        else { unsigned char* img = ws + WS_KVB + ((size_t)((b * 6 + hd) * 260 + (kidx >> 6))) * 16384 + (kidx & 63) * 16;
                            const int c0 = 4 * tn + 2 * h; *(u32x4*)(img + c0 * 1024) = lo; *(u32x4*)(img + (c0 + 1) * 1024) = hi; }
                    }
                }
            } else if (cb < 2304) {
                const int g64 = (cb - 1664) >> 6;
                bf16_t* dst = (bf16_t*)(ws + WS_ZC) + (size_t)tok * 640 + (cb - 1664) + 16 * h;
                float ss = half_sum(sumsq16(acc[tm][T0]) + sumsq16(acc[tm][T0 + 1]));
#pragma unroll
                for (int tn = 0; tn < 2; ++tn) { u32x4 lo, hi; pack16(acc[tm][T0 + tn], lo, hi); *(u32x4*)(dst + tn * 32) = lo; *(u32x4*)(dst + tn * 32 + 8) = hi; }
                if (h == 0) ((float*)(ws + WS_SS))[(size_t)tok * 16 + g64] = ss;
            } else if (cb == 2304) {
                const float ss = half_sum(sumsq16(acc[tm][T0]));
                const float rinv = fast_rsq(ss * (1.0f / 32.0f) + EPS);
                const float* gain = p->c_k_norm + layer * 96 + 64 + 16 * h;
                f32x16 v;
#pragma unroll
                for (int i = 0; i < 16; ++i) v[i] = acc[tm][T0][i] * rinv * gain[i];
                if (tok < NLAT) { const int pp = h ? (kidx & 63) : (kidx >> 6); const float* cs = (const float*)(ws + WS_ROPE) + pp * 16;
#pragma unroll
                    for (int j = 0; j < 8; ++j) { const float c = cs[2 * j], s = cs[2 * j + 1], a = v[j], bb = v[8 + j]; v[j] = a * c - bb * s; v[8 + j] = bb * c + a * s; } }
                u32x4 lo, hi; pack16(v, lo, hi); bf16_t* dst = (bf16_t*)(ws + WS_KR) + (size_t)tok * 32 + 16 * h; *(u32x4*)dst = lo; *(u32x4*)(dst + 8) = hi;
            }
        }
    }
};
struct EpiQup {
    const Params* p; int layer;
    template <int TM, int TN> DEV void run(const f32x16 (&acc)[TM][TN], int mw, int cb, int r, int h) const {
        static_assert(TN == 3, "one 96-column head per wave");
        unsigned char* ws = p->ws; const int hd = cb / 96;
        const float* gain = p->c_q_norm + layer * 96;
        const float QS = 0.10206207261596577f * LOG2E;
#pragma unroll
        for (int tm = 0; tm < TM; ++tm) {
            const int tok = mw + tm * 32 + r; int b, kidx; tok_info(tok, b, kidx);
            const float* ssp = (const float*)(ws + WS_SS) + (size_t)tok * 16;
            const float rq = fast_rsq((ssp[0] + ssp[1] + ssp[2] + ssp[3] + ssp[4] + ssp[5]) * (1.0f / 384.0f) + EPS);
            const float s1 = half_sum(sumsq16(acc[tm][0]) + sumsq16(acc[tm][1])) * rq * rq;
            const float s2 = half_sum(sumsq16(acc[tm][2])) * rq * rq;
            const float r1 = fast_rsq(s1 * (1.0f / 64.0f) + EPS) * rq, r2 = fast_rsq(s2 * (1.0f / 32.0f) + EPS) * rq;
            unsigned char* dst = ws + WS_QC + (size_t)tok * 768 + hd * 128 + 16 * h;
#pragma unroll
            for (int tn = 0; tn < 3; ++tn) { f32x16 v; const float rr = (tn < 2 ? r1 : r2);
#pragma unroll
                for (int i = 0; i < 16; ++i) v[i] = acc[tm][tn][i] * rr * gain[tn * 32 + 16 * h + i];
                if (tn == 2 && tok < NLAT) { const int pp = h ? (kidx & 63) : (kidx >> 6); const float* cs = (const float*)(ws + WS_ROPE) + pp * 16;
#pragma unroll
                    for (int j = 0; j < 8; ++j) { const float c = cs[2 * j], s = cs[2 * j + 1], a = v[j], bb = v[8 + j]; v[j] = a * c - bb * s; v[8 + j] = bb * c + a * s; } }
#pragma unroll
                for (int i = 0; i < 16; ++i) v[i] *= QS * 8.0f;
                *(u32x4*)(dst + tn * 32) = pk_fp8x16(v);
                if (tn == 2) *(u32x4*)(dst + 96) = zero_u32x4(); }
        }
    }
};
struct EpiKVup {
    const Params* p; int layer;
    template <int TM, int TN> DEV void run(const f32x16 (&acc)[TM][TN], int mw, int cb, int r, int h) const {
        static_assert(TN == 2, "64 columns per wave");
        unsigned char* ws = p->ws; const int hd = cb >> 7, isv = (cb >> 6) & 1;
#pragma unroll
        for (int tm = 0; tm < TM; ++tm) {
            if (isv) break;
            const int tok = mw + tm * 32 + r; int b, kidx; tok_info(tok, b, kidx);
            const float* ssp = (const float*)(ws + WS_SS) + (size_t)tok * 16 + 6;
            const float rkv = fast_rsq((ssp[0] + ssp[1] + ssp[2] + ssp[3]) * (1.0f / 256.0f) + EPS);
            unsigned char* img = ws + WS_KVC + ((size_t)((b * 6 + hd) * 130 + (kidx >> 7))) * MLA_IMG;
            const int sub = (kidx >> 6) & 1, key = kidx & 63;
            if (!isv) {
                const float s1 = half_sum(sumsq16(acc[tm][0]) + sumsq16(acc[tm][1])) * rkv * rkv;
                const float r1 = fast_rsq(s1 * (1.0f / 64.0f) + EPS) * rkv;
                const float* gain = p->c_k_norm + layer * 96 + 16 * h;
                unsigned char* kim = img + sub * MLA_KSUB + key * 16;
#pragma unroll
                for (int tn = 0; tn < 2; ++tn) { f32x16 v;
#pragma unroll
                    for (int i = 0; i < 16; ++i) v[i] = acc[tm][tn][i] * r1 * gain[tn * 32 + i];
                    *(u32x4*)(kim + (2 * tn + h) * 1024) = pk_fp8x16(v); }
                { const u32x4* kr = (const u32x4*)((const bf16_t*)(ws + WS_KR) + (size_t)tok * 32 + 16 * h); const u32x4 k0 = kr[0], k1 = kr[1]; f32x16 v;
#pragma unroll
                  for (int q = 0; q < 4; ++q) { v[2 * q] = bflo(k0[q]); v[2 * q + 1] = bfhi(k0[q]); v[8 + 2 * q] = bflo(k1[q]); v[8 + 2 * q + 1] = bfhi(k1[q]); }
                  *(u32x4*)(kim + (4 + h) * 1024) = pk_fp8x16(v); *(u32x4*)(kim + (6 + h) * 1024) = zero_u32x4(); }
            }
        }
        if (isv) {
            const int lane = r + 32 * h, tokl = mw + lane; int b, kidx; tok_info(mw, b, kidx);
            const float* ssp = (const float*)(ws + WS_SS) + (size_t)tokl * 16 + 6;
            const float rkv = fast_rsq((ssp[0] + ssp[1] + ssp[2] + ssp[3]) * (1.0f / 256.0f) + EPS);
            unsigned char* vim = ws + WS_KVC + ((size_t)((b * 6 + hd) * 130 + (kidx >> 7))) * MLA_IMG + MLA_VOFF + ((kidx >> 6) & 1) * MLA_VSUB + r * 16;
#pragma unroll
            for (int tm = 0; tm < TM; ++tm) { float rk[16];
#pragma unroll
                for (int i = 0; i < 16; ++i) rk[i] = __builtin_bit_cast(float, __builtin_amdgcn_ds_bpermute((32 * tm + crow(i, h)) << 2, __builtin_bit_cast(int, rkv)));
#pragma unroll
                for (int tn = 0; tn < 2; ++tn) { f32x16 v;
#pragma unroll
                    for (int i = 0; i < 16; ++i) v[i] = acc[tm][tn][i] * rk[i];
                    *(u32x4*)(vim + (2 * h + tm) * 1024 + tn * 512) = pk_fp8x16(v); } }
        }
    }
};
struct EpiOut {
    const Params* p; int layer;
    template <int TM, int TN> DEV void run(const f32x16 (&acc)[TM][TN], int mw, int cb, int r, int h) const {
        unsigned char* ws = p->ws; bf16_t* X = (bf16_t*)(ws + WS_X);
        const float* mod = (const float*)(ws + WS_MOD) + (size_t)layer * 3 * 6144;
#pragma unroll
        for (int tm = 0; tm < TM; ++tm) {
            const int tok = mw + tm * 32 + r;
            const float* base = tok < NLAT ? p->x + (size_t)tok * 1024 : p->ctx + (size_t)(tok - NLAT) * 1024;
            const float* g1 = mod + mod_row(tok) * 6144 + 2048;
#pragma unroll
            for (int tn = 0; tn < TN; ++tn) { const int col = cb + tn * 32 + 16 * h;
#pragma unroll
                for (int q = 0; q < 4; ++q) { f32x4 bv; const f32x4 gv = *(const f32x4*)(g1 + col + 4 * q); f32x4 o;
                    if (layer == 0) bv = *(const f32x4*)(base + col + 4 * q);
                    else { const u32x2 b2 = *(const u32x2*)(X + (size_t)tok * 1024 + col + 4 * q); bv = (f32x4){bflo(b2[0]), bfhi(b2[0]), bflo(b2[1]), bfhi(b2[1])}; }
#pragma unroll
                    for (int j = 0; j < 4; ++j) o[j] = bv[j] + gv[j] * acc[tm][tn][4 * q + j];
                    *(u32x2*)(X + (size_t)tok * 1024 + col + 4 * q) = (u32x2){cvtpk(o[0], o[1]), cvtpk(o[2], o[3])}; } }
        }
    }
};
struct EpiLogits {
    const Params* p;
    template <int TM, int TN> DEV void run(const f32x16 (&acc)[TM][TN], int mw, int cb, int r, int h) const {
        float* LG = (float*)(p->ws + WS_LG);
#pragma unroll
        for (int tm = 0; tm < TM; ++tm) { const int tok = mw + tm * 32 + r;
#pragma unroll
            for (int tn = 0; tn < TN; ++tn) { const int col = cb + tn * 32 + 16 * h;
#pragma unroll
                for (int q = 0; q < 4; ++q) *(f32x4*)(LG + (size_t)tok * 128 + col + 4 * q) = (f32x4){acc[tm][tn][4 * q], acc[tm][tn][4 * q + 1], acc[tm][tn][4 * q + 2], acc[tm][tn][4 * q + 3]}; } }
    }
};
constexpr int LGP = 73, LG_OFF = 98304, RT_OFF = LG_OFF + 128 * LGP * 4;
struct EpiLogitsLds {
    LAS float* lg; int m0;
    template <int TM, int TN> DEV void run(const f32x16 (&acc)[TM][TN], int mw, int cb, int r, int h) const {
#pragma unroll
        for (int tm = 0; tm < TM; ++tm) { const int row = mw - m0 + tm * 32 + r;
#pragma unroll
            for (int tn = 0; tn < TN; ++tn) { const int col = cb + tn * 32 + 16 * h;
#pragma unroll
                for (int i = 0; i < 16; ++i) if (col + i < 72) lg[row * LGP + col + i] = acc[tm][tn][i]; } }
    }
};
struct EpiMoe1 {
    bf16_t* HB; int slot0;
    template <int TM, int TN> DEV void run(const f32x16 (&acc)[TM][TN], int mw, int cb, int r, int h) const {
#pragma unroll
        for (int tm = 0; tm < TM; ++tm) { const int row = slot0 + mw + tm * 32 + r;
#pragma unroll
            for (int tn = 0; tn < TN; ++tn) { float o[8];
#pragma unroll
                for (int j = 0; j < 8; ++j) o[j] = silu_f(acc[tm][tn][j]) * acc[tm][tn][8 + j];
                const u32x4 w = {cvtpk(o[0], o[1]), cvtpk(o[2], o[3]), cvtpk(o[4], o[5]), cvtpk(o[6], o[7])};
                *(u32x4*)(HB + (size_t)row * 512 + (cb >> 1) + tn * 16 + 8 * h) = w; } }
    }
};
struct EpiMoe2 {
    bf16_t* YS; int slot0;
    template <int TM, int TN> DEV void run(const f32x16 (&acc)[TM][TN], int mw, int cb, int r, int h) const {
#pragma unroll
        for (int tm = 0; tm < TM; ++tm) { const int row = slot0 + mw + tm * 32 + r;
#pragma unroll
            for (int tn = 0; tn < TN; ++tn) { u32x4 lo, hi; pack16(acc[tm][tn], lo, hi); bf16_t* d = YS + (size_t)row * 1024 + cb + tn * 32 + 16 * h; *(u32x4*)d = lo; *(u32x4*)(d + 8) = hi; } }
    }
};

DEV void xpose_item(const float* __restrict__ s0, const float* __restrict__ s1, int ld, int ncols, const float* __restrict__ kscale,
                    bf16_t* __restrict__ dst, int ld_dst, int k0, int nt, int mode, LAS float* tile, bool fp8 = false) {
    const int tid = otid();
#pragma unroll
    for (int rr = 0; rr < 2; ++rr) { const int idx = tid + 512 * rr, krow = idx >> 4, c4 = (idx & 15) * 4; f32x4 v = {0.f, 0.f, 0.f, 0.f};
        if (mode == 0 || mode == 2) { const int c = nt * 64 + c4; if (c < ncols) v = *(const f32x4*)(s0 + (size_t)(k0 + krow) * ld + c); }
        else { const int hid0 = nt * 32; v = (c4 < 32) ? *(const f32x4*)(s0 + (size_t)(k0 + krow) * ld + hid0 + c4) : *(const f32x4*)(s1 + (size_t)(k0 + krow) * ld + hid0 + c4 - 32); }
        const float sc = kscale ? kscale[k0 + krow] : 1.0f;
        tile[krow * 65 + c4] = v[0] * sc; tile[krow * 65 + c4 + 1] = v[1] * sc; tile[krow * 65 + c4 + 2] = v[2] * sc; tile[krow * 65 + c4 + 3] = v[3] * sc; }
    __syncthreads();
    { const int nl = tid >> 3, kc = tid & 7, blk = nl >> 5, rho = nl & 31; int cl;
      if (mode == 0) cl = 32 * blk + perm32(rho);
      else if (mode >= 2) cl = nl;
      else { const int i = (rho & 3) + 4 * (rho >> 3), hh = (rho >> 2) & 1; cl = (i < 8 ? 0 : 32) + 16 * blk + 8 * hh + (i & 7); }
      float v[8];
#pragma unroll
      for (int j = 0; j < 8; ++j) v[j] = tile[(8 * kc + j) * 65 + cl];
      if (fp8) *(u32x2*)((unsigned char*)dst + (size_t)(nt * 64 + nl) * ld_dst + k0 + 8 * kc) = (u32x2){pk_fp8x4(v[0] * 32.f, v[1] * 32.f, v[2] * 32.f, v[3] * 32.f), pk_fp8x4(v[4] * 32.f, v[5] * 32.f, v[6] * 32.f, v[7] * 32.f)};
      else { const u32x4 w = {cvtpk(v[0], v[1]), cvtpk(v[2], v[3]), cvtpk(v[4], v[5]), cvtpk(v[6], v[7])};
      *(u32x4*)(dst + (size_t)(nt * 64 + nl) * ld_dst + k0 + 8 * kc) = w; } }
    __syncthreads();
}

DEV void phase_prologue(const Params& p, LAS char* lds) {
    unsigned char* ws = ows_(p.ws); const int tid = otid(), bid = blockIdx.x, nb = gridDim.x;
    LAS float* tile = (LAS float*)lds;
    for (int it = bid; it < 2 * 48; it += nb) {
        const int l = it / 48, cc = it % 48;
        LAS float* red = (LAS float*)lds;
        const int cq = tid & 31, kg = tid >> 5, kb = kg * 64;
        const float* w = p.w_ada + ((size_t)l * 1024 + kb) * 6144 + cc * 128 + cq * 4;
        f32x4 a0 = {0.f, 0.f, 0.f, 0.f}, a1 = a0, a2 = a0;
        for (int k0 = 0; k0 < 64; k0 += 8) {
            f32x4 wv[8];
#pragma unroll
            for (int q = 0; q < 8; ++q) wv[q] = *(const f32x4*)(w + (size_t)(k0 + q) * 6144);
#pragma unroll
            for (int q = 0; q < 8; ++q) { const int k = kb + k0 + q; const float s0 = silu_f(p.c[k]), s1 = silu_f(p.c[1024 + k]), s2 = silu_f(p.c_ctx[k]); a0 += wv[q] * s0; a1 += wv[q] * s1; a2 += wv[q] * s2; }
        }
#pragma unroll
        for (int e = 0; e < 4; ++e) { red[(kg * 3 + 0) * 128 + cq * 4 + e] = a0[e]; red[(kg * 3 + 1) * 128 + cq * 4 + e] = a1[e]; red[(kg * 3 + 2) * 128 + cq * 4 + e] = a2[e]; }
        __syncthreads();
        if (tid < 384) { const int rw = tid >> 7, c = tid & 127; float sum = 0.f;
#pragma unroll
            for (int g = 0; g < 16; ++g) sum += red[(g * 3 + rw) * 128 + c];
            ((float*)(ws + WS_MOD))[((size_t)l * 3 + rw) * 6144 + cc * 128 + c] = sum + p.b_ada[l * 6144 + cc * 128 + c]; }
        __syncthreads();
    }
    if (bid == 0) {
        for (int i = tid; i < 2048; i += 512) { const int pp = i >> 3, j = i & 7; const float inv = exp2f(-(float)j * 0.125f * 13.287712379549449f); const float ang = (float)pp * inv;
            ((float*)(ws + WS_ROPE))[2 * i] = cosf(ang); ((float*)(ws + WS_ROPE))[2 * i + 1] = sinf(ang); }
        for (int l = 0; l < 2; ++l) {
            float m[7] = {0.f, 0.f, 0.f, 0.f, 0.f, 0.f, 0.f};
            for (int i = tid; i < 6 * 15 * 31; i += 512) m[2] = fmaxf(m[2], fabsf(p.b_rpb[l * 6 * 15 * 31 + i]));
            if (tid < 64) { m[0] = fabsf(p.b_q_norm[l * 64 + tid]); m[1] = fabsf(p.b_k_norm[l * 64 + tid]); m[3] = fabsf(p.c_q_norm[l * 96 + tid]); m[4] = fabsf(p.c_k_norm[l * 96 + tid]); }
            if (tid < 32) { m[5] = fabsf(p.c_q_norm[l * 96 + 64 + tid]); m[6] = fabsf(p.c_k_norm[l * 96 + 64 + tid]); }
            LAS float* red = (LAS float*)lds + 8192;
#pragma unroll
            for (int q = 0; q < 7; ++q) { float v = wave_max(m[q]);
                if ((tid & 63) == 0) red[(tid >> 6) * 8 + q] = v; }
            __syncthreads();
            if (tid == 0) { float r[7];
#pragma unroll
                for (int q = 0; q < 7; ++q) { float v = 0.f;
#pragma unroll
                    for (int wv = 0; wv < 8; ++wv) v = fmaxf(v, red[wv * 8 + q]);
                    r[q] = v; }
                float* sc = (float*)(ws + WS_SCAL) + l * 8;
                sc[0] = ((64.f * r[0] * r[1] * 0.125f + r[2]) * 1.05f + 1.0f) * LOG2E;
                sc[1] = ((64.f * r[3] * r[4] + 32.f * r[5] * r[6]) * 0.10206207261596577f * 1.05f + 1.0f) * LOG2E; }
            __syncthreads();
        }
    }
    for (int it = bid; it < 2 * 128; it += nb) {
        const int l = it >> 7, np = it & 127, col = 32 * (np >> 5) + perm32(np & 31);
        bf16_t* d = (bf16_t*)(ws + WS_WRT) + ((size_t)l * 128 + np) * 3072;
        for (int k = tid; k < 1024; k += 512) { float wv = 0.f;
            if (col < 8) wv = p.moe_w_group[((size_t)l * 1024 + k) * 8 + col]; else if (col < 72) wv = p.moe_w_router[((size_t)l * 1024 + k) * 64 + col - 8];
            d[k] = (bf16_t)(cvtpk_h(wv, 0.f) & 0xffffu); }
    }
    for (int i = bid * 512 + tid; i < 2 * 4 * 128 * 128 / 2; i += nb * 512) { const f32x2 v = *(const f32x2*)(p.a_w_s + 2 * (size_t)i); ((unsigned*)(ws + WS_WSP))[i] = cvtpk(v[0], v[1]); }
    for (int it = bid; it < 2 * (608 + 54 + 48 + 512); it += nb) {
        const int l = it / 1222; int j = it % 1222;
        if (j < 608) { xpose_item(p.w_in + (size_t)l * 1024 * INW, nullptr, INW, INW, nullptr, (bf16_t*)(ws + WS_WIN) + (size_t)l * INWP * 1024, 1024, (j % 16) * 64, j / 16, (j / 16) < 36 ? 2 : 0, tile); continue; }
        j -= 608;
        if (j < 54) { xpose_item(p.c_w_q_up + (size_t)l * 384 * 576, nullptr, 576, 576, p.c_q_a_norm + l * 384, (bf16_t*)(ws + WS_WQ) + (size_t)l * 576 * 384, 384, (j % 6) * 64, j / 6, 0, tile); continue; }
        j -= 54;
        if (j < 48) { xpose_item(p.c_w_kv_up + (size_t)l * 256 * 768, nullptr, 768, 768, p.c_kv_a_norm + l * 256, (bf16_t*)(ws + WS_WKV) + (size_t)l * 768 * 256, 256, (j % 4) * 64, j / 4, 0, tile); continue; }
        j -= 48;
        if (j < 256) xpose_item(p.w_out + (size_t)l * 1024 * 1024, nullptr, 1024, 1024, nullptr, (bf16_t*)(ws + WS_WOUT) + (size_t)l * 1024 * 1024, 1024, (j % 16) * 64, j / 16, 2, tile);
        else { j -= 256; xpose_item(p.w_out + (size_t)l * 1024 * 1024, nullptr, 1024, 1024, nullptr, (bf16_t*)(ws + WS_WOUTP) + (size_t)l * 1024 * 1024, 1024, (j % 16) * 64, j / 16, 0, tile); }
    }
}

DEV void norm_store(const Params& p, int tok, const float (&xv)[2][8], const float* __restrict__ gain, const float* __restrict__ sh, const float* __restrict__ scl, bool with_lo, int lane) {
    float ss = 0.f;
#pragma unroll
    for (int j = 0; j < 2; ++j)
#pragma unroll
        for (int i = 0; i < 8; ++i) ss += xv[j][i] * xv[j][i];
    ss = wave_sum(ss);
    const float rinv = fast_rsq(ss * (1.0f / 1024.0f) + EPS);
    bf16_t* H = (bf16_t*)(p.ws + WS_H) + (size_t)tok * HLD;
#pragma unroll
    for (int j = 0; j < 2; ++j) { const int col = 8 * lane + 512 * j; float y[8];
        const f32x4 g0 = *(const f32x4*)(gain + col), g1 = *(const f32x4*)(gain + col + 4), s0 = *(const f32x4*)(scl + col), s1 = *(const f32x4*)(scl + col + 4), h0 = *(const f32x4*)(sh + col), h1 = *(const f32x4*)(sh + col + 4);
#pragma unroll
        for (int i = 0; i < 4; ++i) { y[i] = xv[j][i] * rinv * g0[i] * (1.0f + s0[i]) + h0[i]; y[4 + i] = xv[j][4 + i] * rinv * g1[i] * (1.0f + s1[i]) + h1[i]; }
        if (!with_lo) { const u32x4 w = {cvtpk(y[0], y[1]), cvtpk(y[2], y[3]), cvtpk(y[4], y[5]), cvtpk(y[6], y[7])}; *(u32x4*)(H + col) = w; }
        else { *(u32x2*)((unsigned char*)H + col) = (u32x2){pk_fp8x4(y[0], y[1], y[2], y[3]), pk_fp8x4(y[4], y[5], y[6], y[7])};
            const u32x4 wl = {cvtpk_h(y[0], y[1]), cvtpk_h(y[2], y[3]), cvtpk_h(y[4], y[5]), cvtpk_h(y[6], y[7])};
            *(u32x4*)(H + 1024 + col) = wl; } }
}
DEV void load_row(const float* __restrict__ src, float (&xv)[2][8], int lane) {
#pragma unroll
    for (int j = 0; j < 2; ++j) { const f32x4 a = *(const f32x4*)(src + 8 * lane + 512 * j), b = *(const f32x4*)(src + 8 * lane + 512 * j + 4);
#pragma unroll
        for (int i = 0; i < 4; ++i) { xv[j][i] = a[i]; xv[j][4 + i] = b[i]; } }
}
DEV void load_row_bf(const bf16_t* __restrict__ src, float (&xv)[2][8], int lane) {
#pragma unroll
    for (int j = 0; j < 2; ++j) { const u32x4 a = *(const u32x4*)(src + 8 * lane + 512 * j);
#pragma unroll
        for (int e = 0; e < 4; ++e) { xv[j][2 * e] = bflo(a[e]); xv[j][2 * e + 1] = bfhi(a[e]); } }
}
DEV void phase_norm(const Params& p, int layer, int which) {
    const int tid = otid(), lane = tid & 63, gw = blockIdx.x * 8 + (tid >> 6), nw = gridDim.x * 8;
    const float* mod = (const float*)(p.ws + WS_MOD) + (size_t)layer * 3 * 6144;
    const int ntok = (which == 1 && layer == 1) ? NLAT : NTOK;
    for (int tok0 = gw * 4; tok0 < ntok; tok0 += nw * 4) {
        float xv[4][2][8];
#pragma unroll
        for (int q = 0; q < 4; ++q) { const int tok = tok0 + q;
            if (which == 0 && layer == 0) load_row(tok < NLAT ? p.x + (size_t)tok * 1024 : p.ctx + (size_t)(tok - NLAT) * 1024, xv[q], lane);
            else load_row_bf((const bf16_t*)(p.ws + WS_X) + (size_t)tok * 1024, xv[q], lane); }
#pragma unroll
        for (int q = 0; q < 4; ++q) { const int tok = tok0 + q; const float* m = mod + mod_row(tok) * 6144;
            if (which == 0) norm_store(p, tok, xv[q], p.norm_mix + layer * 1024, m, m + 1024, false, lane);
            else norm_store(p, tok, xv[q], p.norm_ffn + layer * 1024, m + 3072, m + 4096, true, lane); }
    }
}

DEV void gmlp_unit(const Params& p, int layer, int chunk, LAS char* lds) {
    unsigned char* ws = ows_(p.ws); const int tid = otid(), lane = tid & 63, wid = tid >> 6, r = lane & 31, h = lane >> 5;
    const int tok0 = chunk * 128;
    const bf16_t* ZA = (const bf16_t*)(ws + WS_ZA);
    { const int t = tid >> 2, hd = tid & 3; const bf16_t* src = ZA + (size_t)(tok0 + t) * 512 + 256 + hd * 64; float v[64]; float ss = 0.f;
#pragma unroll
      for (int c = 0; c < 8; ++c) { const u32x4 w = *(const u32x4*)(src + 8 * c);
#pragma unroll
          for (int q = 0; q < 4; ++q) { v[8 * c + 2 * q] = bflo(w[q]); v[8 * c + 2 * q + 1] = bfhi(w[q]); } }
#pragma unroll
      for (int i = 0; i < 64; ++i) ss += v[i] * v[i];
      ss += lx1(ss); ss += lx2(ss);
      const float rinv = fast_rsq(ss * (1.0f / 256.0f) + EPS);
      const float* gain = p.a_v_norm + layer * 256 + hd * 64;
      LAS char* img = lds + hd * 16384 + t * 64;
#pragma unroll
      for (int dh = 0; dh < 2; ++dh)
#pragma unroll
          for (int hh = 0; hh < 2; ++hh)
#pragma unroll
              for (int g = 0; g < 4; ++g) { const int d = 32 * dh + 16 * hh + 4 * g; float y[4];
#pragma unroll
                  for (int j = 0; j < 4; ++j) y[j] = v[d + j] * rinv * gain[d + j];
                  const u32x2 w = {cvtpk(y[0], y[1]), cvtpk(y[2], y[3])};
                  *(LAS u32x2*)(img + dh * 8192 + (8 * g + 4 * hh) * 2) = w; } }
    __syncthreads();
    const int hd = wid >> 1, ph = wid & 1;
    const bf16_t* W = (const bf16_t*)(ws + WS_WSP) + ((size_t)(layer * 4 + hd)) * 128 * 128;
    f32x16 acc[2][2];
#pragma unroll
    for (int a = 0; a < 2; ++a)
#pragma unroll
        for (int b = 0; b < 2; ++b)
#pragma unroll
            for (int i = 0; i < 16; ++i) acc[a][b][i] = 0.f;
    LAS char* vb = lds + hd * 16384 + 32 * ((lane >> 4) & 1) + 8 * (lane & 3) + ((lane & 15) >> 2) * 64;
#pragma unroll
    for (int s = 0; s < 8; ++s) {
        bf16x8 wf[2], vf[2];
#pragma unroll
        for (int pb = 0; pb < 2; ++pb) wf[pb] = *(const bf16x8*)(W + (size_t)(ph * 64 + pb * 32 + r) * 128 + 16 * s + 8 * h);
#pragma unroll
        for (int dh = 0; dh < 2; ++dh) { LAS char* a = vb + dh * 8192 + (16 * s + 8 * h) * 64; vf[dh] = cat4(lds_tr(a), lds_tr(a + 256)); }
#pragma unroll
        for (int pb = 0; pb < 2; ++pb)
#pragma unroll
            for (int dh = 0; dh < 2; ++dh) acc[pb][dh] = MFMA(vf[dh], wf[pb], acc[pb][dh]);
    }
    bf16_t* MIX = (bf16_t*)(ws + WS_MIX);
#pragma unroll
    for (int pb = 0; pb < 2; ++pb) { const int pp = ph * 64 + pb * 32 + r, tok = tok0 + pp; const float bias = p.a_b_s[(layer * 4 + hd) * 128 + pp];
#pragma unroll
        for (int dh = 0; dh < 2; ++dh) { const int col = hd * 64 + dh * 32 + 16 * h; const u32x4 u0 = *(const u32x4*)(ZA + (size_t)tok * 512 + col), u1 = *(const u32x4*)(ZA + (size_t)tok * 512 + col + 8); f32x16 o;
#pragma unroll
            for (int q = 0; q < 4; ++q) { o[2 * q] = bflo(u0[q]) * (acc[pb][dh][2 * q] + bias); o[2 * q + 1] = bfhi(u0[q]) * (acc[pb][dh][2 * q + 1] + bias);
                o[8 + 2 * q] = bflo(u1[q]) * (acc[pb][dh][8 + 2 * q] + bias); o[8 + 2 * q + 1] = bfhi(u1[q]) * (acc[pb][dh][8 + 2 * q + 1] + bias); }
            u32x4 lo, hi; pack16(o, lo, hi); *(u32x4*)(MIX + (size_t)tok * 1024 + col) = lo; *(u32x4*)(MIX + (size_t)tok * 1024 + col + 8) = hi; } }
    __syncthreads();
}

template <int ND> DEV void qk_tile(LAS char* kimg, const bf16x8 (&qf)[ND], float cinit, f32x16 (&s)[2], int r, int h) {
#pragma unroll
    for (int kb = 0; kb < 2; ++kb)
#pragma unroll
        for (int i = 0; i < 16; ++i) s[kb][i] = cinit;
#pragma unroll
    for (int d0 = 0; d0 < ND; ++d0) {
#pragma unroll
        for (int kb = 0; kb < 2; ++kb) { const bf16x8 kf = lds_b128(kimg + (2 * d0 + h) * 1024 + (32 * kb + r) * 16); s[kb] = MFMA(kf, qf[d0], s[kb]); }
    }
}
DEV void pv_tile(LAS char* vimg, const f32x16 (&pr)[2], f32x16 (&o)[2], int lane) {
    const int h = lane >> 5;
    LAS char* vb = vimg + 32 * ((lane >> 4) & 1) + 8 * (lane & 3) + (4 * h + ((lane & 15) >> 2)) * 64;
#pragma unroll
    for (int ks = 0; ks < 4; ++ks) { const int kb = ks >> 1, s8 = (ks & 1) * 8;
        const u32x4 pw = {cvtpk(pr[kb][s8], pr[kb][s8 + 1]), cvtpk(pr[kb][s8 + 2], pr[kb][s8 + 3]), cvtpk(pr[kb][s8 + 4], pr[kb][s8 + 5]), cvtpk(pr[kb][s8 + 6], pr[kb][s8 + 7])};
        const bf16x8 pf = __builtin_bit_cast(bf16x8, pw);
#pragma unroll
        for (int dh = 0; dh < 2; ++dh) { LAS char* a = vb + dh * 4096 + ks * 1024; const bf16x8 vf = cat4(lds_tr(a), lds_tr(a + 512)); o[dh] = MFMA(vf, pf, o[dh]); }
    }
}
DEV void attn_store(bf16_t* dst, const f32x16 (&o)[2], float lsum, int h) {
    const float inv = fast_rcp(half_sum(lsum));
#pragma unroll
    for (int dh = 0; dh < 2; ++dh) { f32x16 v;
#pragma unroll
        for (int i = 0; i < 16; ++i) v[i] = o[dh][i] * inv;
        u32x4 lo, hi; pack16(v, lo, hi); *(u32x4*)(dst + dh * 32 + 16 * h) = lo; *(u32x4*)(dst + dh * 32 + 16 * h + 8) = hi; }
}

DEV void na_unit(const Params& p, int layer, int b, int hd, int rg, bool ctxq, LAS char* lds) {
    unsigned char* ws = ows_(p.ws); const int tid = otid(), lane = tid & 63, wid = tid >> 6, r = lane & 31, h = lane >> 5;
    constexpr int STG = 16384, TB_OFF = 3 * STG;
    LAS float* tb = (LAS float*)(lds + TB_OFF);
    const float cinit = -((const float*)(ws + WS_SCAL))[layer * 8 + 0];
    int qrow = 0, cq = 0, tok, T0 = 0, ntl = 0, my0 = 0;
    if (!ctxq) { qrow = rg * 4 + (wid >> 1); cq = 32 * (wid & 1) + r; tok = b * SEQ + qrow * 64 + cq;
        const int R = rg * 4; T0 = min(max(R - 4, 0), 248); const int T1 = min(max(R + 3 - 4, 0), 248) + 7; ntl = T1 - T0 + 1; my0 = min(max(qrow - 4, 0), 248);
        for (int i = tid; i < 15 * 128; i += 512) { const int dr = i >> 7, d = (i & 127) - 64; tb[i] = (d >= -15 && d <= 15) ? p.b_rpb[((layer * 6 + hd) * 15 + dr) * 31 + d + 15] * LOG2E : -1e30f; }
    } else tok = NLAT + b * 256 + 32 * wid + r;
    const int nt = ntl + 4;
    bf16x8 qf[4];
#pragma unroll
    for (int d0 = 0; d0 < 4; ++d0) qf[d0] = *(const bf16x8*)((const bf16_t*)(ws + WS_QB) + (size_t)tok * 384 + hd * 64 + 16 * d0 + 8 * h);
    const unsigned char* imgs = ws + WS_KVB + (size_t)((b * 6 + hd) * 260) * 16384;
    const unsigned ldsw = (unsigned)__builtin_amdgcn_readfirstlane((int)(lds_addr(lds) + (unsigned)(wid * 2048)));
#define NA_ISSUE(j_, st_) do { const int ti_ = (j_) < ntl ? T0 + (j_) : 256 + (j_) - ntl; const unsigned char* s_ = imgs + (size_t)ti_ * 16384 + wid * 2048 + lane * 16; const unsigned d_ = ldsw + (unsigned)((st_) * STG); \
    glds16a(s_, d_); glds16a(s_ + 1024, d_ + 1024); } while (0)
    NA_ISSUE(0, 0); NA_ISSUE(1, 1);
    f32x16 o[2];
#pragma unroll
    for (int dh = 0; dh < 2; ++dh)
#pragma unroll
        for (int i = 0; i < 16; ++i) o[dh][i] = 0.f;
    float lsum = 0.f;
    const int c0 = min(max(cq - 8, 0), 48);
    int st = 0, stn = 2;
    for (int j = 0; j < nt; ++j) {
        if (j + 1 < nt) WAITV(2); else WAITV(0);
        SBAR();
        if (j + 2 < nt) NA_ISSUE(j + 2, stn);
        LAS char* img = lds + st * STG;
        const bool local = j < ntl; const int kr = T0 + j;
        if (!local || (kr >= my0 && kr < my0 + 8)) {
            f32x16 s[2]; qk_tile<4>(img, qf, cinit, s, r, h);
            if (local) { LAS float* trow = tb + (kr - qrow + 7) * 128 + (4 * h - cq + 64);
#pragma unroll
                for (int kb = 0; kb < 2; ++kb)
#pragma unroll
                    for (int i = 0; i < 16; ++i) { const int kc0 = 32 * kb + (i & 3) + 8 * (i >> 2); const float bias = trow[kc0];
                        const bool inw = (unsigned)(kc0 + 4 * h - c0) < 16u; s[kb][i] = inw ? ex2(s[kb][i] + bias) : 0.f; }
            } else {
#pragma unroll
                for (int kb = 0; kb < 2; ++kb)
#pragma unroll
                    for (int i = 0; i < 16; ++i) s[kb][i] = ex2(s[kb][i]);
            }
#pragma unroll
            for (int kb = 0; kb < 2; ++kb)
#pragma unroll
                for (int i = 0; i < 16; ++i) lsum += s[kb][i];
            pv_tile(img + 8192, s, o, lane);
        }
        st = (st == 2) ? 0 : st + 1; stn = (stn == 2) ? 0 : stn + 1;
    }
#undef NA_ISSUE
    attn_store((bf16_t*)(ws + WS_MIX) + (size_t)tok * 1024 + 256 + hd * 64, o, lsum, h);
    SBAR();
    __syncthreads();
}

struct SideJob { int g; int le; int j; f32x4 v0, v1; };
constexpr int SJ_TILE_OFF = 3 * MLA_IMG;
struct SjDesc { const float* s0; const float* s1; unsigned char* dst; int ld, ld_dst, k0, nt, mode; };
DEV SjDesc sj_desc(const Params& p, int layer, int le_, int j) {
    SjDesc d; const int le = layer * 64 + le_;
    if (j < 256) { d.s0 = p.moe_w1 + (size_t)le * 1024 * 512; d.s1 = p.moe_w3 + (size_t)le * 1024 * 512; d.dst = p.ws + WS_W13 + (size_t)le * 1024 * 1024; d.ld = 512; d.ld_dst = 1024; d.k0 = (j & 15) * 64; d.nt = j >> 4; d.mode = 3; }
    else { const int jj = j - 256; d.s0 = p.moe_w2 + (size_t)le * 512 * 1024; d.s1 = d.s0; d.dst = p.ws + WS_W2 + (size_t)le * 1024 * 512; d.ld = 1024; d.ld_dst = 512; d.k0 = (jj & 7) * 64; d.nt = jj >> 3; d.mode = 2; }
    return d;
}
DEV void sj_advance(SideJob& sj) { sj.j += (int)gridDim.x; while (sj.j >= 384) { sj.j -= 384; ++sj.le; } }
DEV void sj_tick(const Params& p, int layer, SideJob& sj, LAS char* lds, int tid) {
    LAS float* tile = (LAS float*)(lds + SJ_TILE_OFF);
    const int ph = sj.g & 3; ++sj.g;
    if (sj.le >= 64 || ph == 3) return;
    const SjDesc d = sj_desc(p, layer, sj.le, sj.j);
    if (ph == 0) {
        const int krow = tid >> 4, c4 = (tid & 15) * 4;
        const float* a0 = (d.mode == 0 || d.mode == 2) ? d.s0 + (size_t)(d.k0 + krow) * d.ld + d.nt * 64 + c4
                                        : ((c4 < 32) ? d.s0 + (size_t)(d.k0 + krow) * 512 + d.nt * 32 + c4 : d.s1 + (size_t)(d.k0 + krow) * 512 + d.nt * 32 + c4 - 32);
        sj.v0 = __builtin_nontemporal_load((const f32x4*)a0); sj.v1 = __builtin_nontemporal_load((const f32x4*)(a0 + (size_t)32 * d.ld));
    } else if (ph == 1) {
        const int krow = tid >> 4, c4 = (tid & 15) * 4;
        LAS float* t0 = tile + krow * 65 + c4; LAS float* t1 = t0 + 32 * 65;
        t0[0] = sj.v0[0]; t0[1] = sj.v0[1]; t0[2] = sj.v0[2]; t0[3] = sj.v0[3]; t1[0] = sj.v1[0]; t1[1] = sj.v1[1]; t1[2] = sj.v1[2]; t1[3] = sj.v1[3];
    } else {
        const int nl = tid >> 3, kc = tid & 7, blk = nl >> 5, rho = nl & 31; int cl;
        if (d.mode == 0) cl = 32 * blk + perm32(rho);
        else if (d.mode >= 2) cl = nl;
        else { const int i = (rho & 3) + 4 * (rho >> 3), hh = (rho >> 2) & 1; cl = (i < 8 ? 0 : 32) + 16 * blk + 8 * hh + (i & 7); }
        float v[8];
#pragma unroll
        for (int j = 0; j < 8; ++j) v[j] = tile[(8 * kc + j) * 65 + cl];
        __builtin_nontemporal_store((u32x2){pk_fp8x4(v[0] * 32.f, v[1] * 32.f, v[2] * 32.f, v[3] * 32.f), pk_fp8x4(v[4] * 32.f, v[5] * 32.f, v[6] * 32.f, v[7] * 32.f)}, (u32x2*)(d.dst + (size_t)(d.nt * 64 + nl) * d.ld_dst + d.k0 + 8 * kc));
        sj_advance(sj);
    }
}

#define MLA_SB() __builtin_amdgcn_sched_barrier(0)
#define MLA_PIN(x) asm volatile("" : "+v"(x))
#define MLA_KF(kp, g) lds_b128((kp) + ((g) >> 1) * 2048 + ((g) & 1) * 512)
#define MLA_VF(vp, g) cat4(lds_tr((vp) + ((g) & 1) * 4096 + ((g) >> 1) * 1024), lds_tr((vp) + ((g) & 1) * 4096 + ((g) >> 1) * 1024 + 512))
#define MFMA8(a, b, c) __builtin_amdgcn_mfma_scale_f32_32x32x64_f8f6f4((a), (b), (c), 0, 0, 0, 0x7f7f7f7f, 0, 0x7c7c7c7c)
DEV v8i mla_kf8(LAS char* kp, int kb, int sx) {
    const u32x4 a = *(LAS u32x4*)(kp + sx * 4096 + kb * 512), b = *(LAS u32x4*)(kp + sx * 4096 + 1024 + kb * 512);
    return (v8i){(int)a[0], (int)a[1], (int)a[2], (int)a[3], (int)b[0], (int)b[1], (int)b[2], (int)b[3]}; }
#define MFMA8PV(a, b, c) __builtin_amdgcn_mfma_scale_f32_32x32x64_f8f6f4((a), (b), (c), 0, 1, 0, 0x7f7f7f7f, 0, 0x7f7f7f7f)
DEV v8i mla_vf8(LAS char* vp, int dh) {
    const u32x4 a = *(LAS u32x4*)(vp + dh * 512), b = *(LAS u32x4*)(vp + dh * 512 + 1024);
    return (v8i){(int)a[0], (int)a[1], (int)a[2], (int)a[3], (int)b[0], (int)b[1], (int)b[2], (int)b[3]}; }
DEV unsigned pk_bf8x4(float a, float b, float c, float d, int old = 0) { int w = __builtin_amdgcn_cvt_pk_bf8_f32(a, b, old, false); w = __builtin_amdgcn_cvt_pk_bf8_f32(c, d, w, true); return (unsigned)w; }
template <int VAR> DEV void mla_step(f32x16& C0, f32x16& C1, f32x16& P0, f32x16& P1, f32x16& o0, f32x16& o1, f32x16& lacc,
                  const v8i (&qf)[2], const f32x16& cini, LAS char* kp, LAS char* vp, v8i& pw) {
    v8i kf[2], vf[2];
    const v8i ones8 = {0x38383838, 0x38383838, 0x38383838, 0x38383838, 0x38383838, 0x38383838, 0x38383838, 0x38383838};
    kf[0] = mla_kf8(kp, 0, 0); kf[1] = mla_kf8(kp, 1, 0);
    MLA_SB();
#pragma unroll
    for (int g = 0; g < 4; ++g) {
        const int kb = g & 1, sx = g >> 1;
        if (kb) C1 = MFMA8(kf[1], qf[sx], sx == 0 ? cini : C1); else C0 = MFMA8(kf[0], qf[sx], sx == 0 ? cini : C0);
        if (g < 2) kf[kb] = mla_kf8(kp, kb, 1);
        if (g >= 2) vf[g - 2] = mla_vf8(vp, g - 2);
#pragma unroll
        for (int j = 0; j < 2; ++j) { const int w = 2 * g + j, e = 4 * w;
            if (VAR == 3) pw[w] = __builtin_bit_cast(int, (e < 16) ? P0[e] : P1[e - 16]);
            else pw[w] = (int)((e < 16) ? pk_bf8x4(P0[e], P0[e + 1], P0[e + 2], P0[e + 3], pw[w]) : pk_bf8x4(P1[e - 16], P1[e - 15], P1[e - 14], P1[e - 13], pw[w])); }
        if (g == 3) MLA_PIN(pw);
        MLA_SB();
    }
#pragma unroll
    for (int g = 0; g < 3; ++g) {
        if (g == 0) o0 = MFMA8PV(vf[0], pw, o0); else if (g == 1) o1 = MFMA8PV(vf[1], pw, o1); else lacc = MFMA8PV(ones8, pw, lacc);
        const int e0 = (g * 32) / 3, e1 = ((g + 1) * 32) / 3;
#pragma unroll
        for (int e = e0; e < e1; ++e) { if (VAR == 2 || VAR == 3) continue; if (e < 16) C0[e] = ex2(C0[e]); else C1[e - 16] = ex2(C1[e - 16]); }
        if (g < 2) MLA_PIN(C0);
        if (g > 0) MLA_PIN(C1);
        MLA_SB();
    }
}
template <int VAR> DEV void mla_unit(const Params& p, int layer, int b, int hd, int tokbase, int t0, int t1, LAS char* lds, SideJob& sj) {
    unsigned char* ws = ows_(p.ws); const int tid = otid(), lane = tid & 63, wid = tid >> 6, r = lane & 31, h = lane >> 5;
    constexpr int STG = MLA_IMG;
    const float cinit = 15.0f - ((const float*)(ws + WS_SCAL))[layer * 8 + 1];
    const int tok = tokbase + 32 * wid + r;
    v8i qf[2];
#pragma unroll
    for (int sx = 0; sx < 2; ++sx) { const u32x4* q8 = (const u32x4*)(ws + WS_QC + (size_t)tok * 768 + hd * 128 + 64 * sx + 32 * h); const u32x4 a = q8[0], bq = q8[1];
        qf[sx] = (v8i){(int)a[0], (int)a[1], (int)a[2], (int)a[3], (int)bq[0], (int)bq[1], (int)bq[2], (int)bq[3]}; }
    const unsigned char* imgs = ws + WS_KVC + (size_t)((b * 6 + hd) * 130) * MLA_IMG;
    const unsigned ldsw = (unsigned)__builtin_amdgcn_readfirstlane((int)(lds_addr(lds) + (unsigned)(wid * (STG / 8))));
#define MLA_ISSUE(t_, st_) do { const unsigned char* s_ = imgs + (size_t)(t_) * MLA_IMG + wid * (STG / 8) + lane * 16; const unsigned d_ = ldsw + (unsigned)((st_) * STG); \
    _Pragma("unroll") for (int i_ = 0; i_ < STG / 8192; ++i_) glds16a(s_ + i_ * 1024, d_ + i_ * 1024); } while (0)
    f32x16 cini, sA0, sA1, sB0, sB1, o0, o1, lacc;
#pragma unroll
    for (int i = 0; i < 16; ++i) { cini[i] = cinit; o0[i] = 0.f; o1[i] = 0.f; lacc[i] = 0.f; }
    const unsigned koffl = (unsigned)(2 * h * 1024 + r * 16);
    const unsigned voffl = (unsigned)MLA_VOFF + (unsigned)(2 * h * 1024 + r * 16);
    const int ns = t1 - t0;
    MLA_ISSUE(t0, 0);
    WAITV(0); SBAR();
    if (ns > 1) MLA_ISSUE(t0 + 1, 1);
    { LAS char* kp = lds + koffl;
      sA0 = MFMA8(mla_kf8(kp, 0, 0), qf[0], cini); sA1 = MFMA8(mla_kf8(kp, 1, 0), qf[0], cini);
      sA0 = MFMA8(mla_kf8(kp, 0, 1), qf[1], sA0); sA1 = MFMA8(mla_kf8(kp, 1, 1), qf[1], sA1);
#pragma unroll
      for (int i = 0; i < 16; ++i) { sA0[i] = ex2(sA0[i]); sA1[i] = ex2(sA1[i]); } }
    int slot = 0;
    v8i pw = {0, 0, 0, 0, 0, 0, 0, 0};
    for (int s = 0; s < ns; ++s) {
        sj_tick(p, layer, sj, lds, tid);
        { LAS char* base = lds + slot * STG; mla_step<VAR>(sB0, sB1, sA0, sA1, o0, o1, lacc, qf, cini, base + MLA_KSUB + koffl, base + voffl, pw); }
        if (s + 1 < ns) {
            const int nslot = (slot == 2) ? 0 : slot + 1;
            WAITV(0); SBAR();
            if (s + 2 < ns) MLA_ISSUE(t0 + s + 2, (nslot == 2) ? 0 : nslot + 1);
            { LAS char* nb = lds + nslot * STG; LAS char* ob = lds + slot * STG; mla_step<VAR>(sA0, sA1, sB0, sB1, o0, o1, lacc, qf, cini, nb + koffl, ob + MLA_VSUB + voffl, pw); }
            slot = nslot;
        }
    }
    {
#pragma unroll
      for (int w = 0; w < 8; ++w) { const int e = 4 * w; pw[w] = (int)((e < 16) ? pk_bf8x4(sB0[e], sB0[e + 1], sB0[e + 2], sB0[e + 3]) : pk_bf8x4(sB1[e - 16], sB1[e - 15], sB1[e - 14], sB1[e - 13])); }
      LAS char* vp = lds + slot * STG + MLA_VSUB + voffl;
      const v8i ones8 = {0x38383838, 0x38383838, 0x38383838, 0x38383838, 0x38383838, 0x38383838, 0x38383838, 0x38383838};
      o0 = MFMA8PV(mla_vf8(vp, 0), pw, o0); o1 = MFMA8PV(mla_vf8(vp, 1), pw, o1); lacc = MFMA8PV(ones8, pw, lacc); }
#undef MLA_ISSUE
    if (VAR == 0 || lacc[0] == -1.2345e-30f) { f32x16 oo[2] = {o0, o1}; attn_store((bf16_t*)(ws + WS_MIX) + (size_t)tok * 1024 + 640 + hd * 64, oo, 0.5f * lacc[0], h); }
    SBAR();
    __syncthreads();
}

DEV void phase_route(const Params& p, int layer, LAS char* lds) {
    unsigned char* ws = ows_(p.ws); const int ntok = layer == 0 ? NTOK : NLAT;
    unsigned* cnt = (unsigned*)(ws + WS_CTL) + CW_CNT + 2048 * layer;
    int* list = (int*)(ws + WS_LIST);
    LAS unsigned* hist = (LAS unsigned*)lds; LAS unsigned* gbase = hist + 64;
    const int tid = otid(), per = (ntok + (int)gridDim.x - 1) / (int)gridDim.x;
    const int tok = blockIdx.x * per + tid; const bool act = tid < per && tok < ntok;
    if (tid < 64) hist[tid] = 0u;
    __syncthreads();
    int ea = 0, eb = 0; float w1 = 0.f, w2 = 0.f; unsigned la = 0, lb = 0;
    if (act) {
        const float* lg = (const float*)(ws + WS_LG) + (size_t)tok * 128;
        float gl[8];
#pragma unroll
        for (int q = 0; q < 2; ++q) { const f32x4 v = *(const f32x4*)(lg + 4 * q); gl[4 * q] = v[0]; gl[4 * q + 1] = v[1]; gl[4 * q + 2] = v[2]; gl[4 * q + 3] = v[3]; }
        int g = 0; float gm = gl[0];
#pragma unroll
        for (int j = 1; j < 8; ++j) if (gl[j] > gm) { gm = gl[j]; g = j; }
        float gs = 0.f;
#pragma unroll
        for (int j = 0; j < 8; ++j) gs += __expf(gl[j] - gm);
        const float gate = 1.0f / gs;
        float el[8]; { const f32x4 a = *(const f32x4*)(lg + 8 + 8 * g), c = *(const f32x4*)(lg + 12 + 8 * g); el[0] = a[0]; el[1] = a[1]; el[2] = a[2]; el[3] = a[3]; el[4] = c[0]; el[5] = c[1]; el[6] = c[2]; el[7] = c[3]; }
        int i1 = 0; float m1 = el[0];
#pragma unroll
        for (int j = 1; j < 8; ++j) if (el[j] > m1) { m1 = el[j]; i1 = j; }
        int i2 = -1; float m2 = -3.0e38f;
#pragma unroll
        for (int j = 0; j < 8; ++j) if (j != i1 && el[j] > m2) { m2 = el[j]; i2 = j; }
        const float e2 = __expf(m2 - m1); w1 = gate / (1.0f + e2); w2 = gate * e2 / (1.0f + e2);
        ea = g * 8 + i1; eb = g * 8 + i2;
        la = __hip_atomic_fetch_add(&hist[ea], 1u, __ATOMIC_RELAXED, __HIP_MEMORY_SCOPE_WORKGROUP);
        lb = __hip_atomic_fetch_add(&hist[eb], 1u, __ATOMIC_RELAXED, __HIP_MEMORY_SCOPE_WORKGROUP);
    }
    __syncthreads();
    if (tid < 64) { const unsigned c = hist[tid]; gbase[tid] = c ? atomicAdd(&cnt[tid * 32], c) : 0u; }
    __syncthreads();
    if (act) {
        const unsigned pa = gbase[ea] + la, pb = gbase[eb] + lb;
        list[(size_t)ea * MOE_CAP + pa] = tok; list[(size_t)eb * MOE_CAP + pb] = tok;
        ((u32x4*)(ws + WS_TIE))[tok] = (u32x4){((unsigned)ea << 16) | pa, ((unsigned)eb << 16) | pb, __float_as_uint(w1), __float_as_uint(w2)};
    }
    __syncthreads();
}
template <int ROWS> DEV void ffn_front_unit(const Params& p, int layer, int m0, LAS char* lds) {
    unsigned char* ws = ows_(p.ws); const int tid = otid(), lane = tid & 63, wid = tid >> 6;
    const float* mod = (const float*)(ws + WS_MOD) + (size_t)layer * 3 * 6144;
    for (int r0 = wid * 4; r0 < ROWS; r0 += 32) {
        float xv[4][2][8];
#pragma unroll
        for (int q = 0; q < 4; ++q) load_row_bf((const bf16_t*)(ws + WS_X) + (size_t)(m0 + r0 + q) * 1024, xv[q], lane);
#pragma unroll
        for (int q = 0; q < 4; ++q) { const int tok = m0 + r0 + q; const float* m = mod + mod_row(tok) * 6144; norm_store(p, tok, xv[q], p.norm_ffn + layer * 1024, m + 3072, m + 4096, true, lane); } }
    asm volatile("s_waitcnt vmcnt(0)" ::: "memory");
    __syncthreads();
    if (wid == 0) { __builtin_amdgcn_fence(__ATOMIC_ACQUIRE, "agent"); asm volatile("s_waitcnt vmcnt(0)" ::: "memory"); }
    __syncthreads();
    LAS float* lg = (LAS float*)(lds + LG_OFF);
    { EpiLogitsLds E{lg, m0};
      if (ROWS == 128) gemm_unit<128, 128, 4, 2, 3, EpiLogitsLds, true>((const bf16_t*)(ws + WS_H) + 1024, HLD, nullptr, 0, m0, 1 << 30, (const bf16_t*)(ws + WS_WRT) + (size_t)layer * 128 * 3072, 3072, 0, 16, lds, E);
      else gemm_unit<64, 128, 2, 4, 3, EpiLogitsLds, true>((const bf16_t*)(ws + WS_H) + 1024, HLD, nullptr, 0, m0, 1 << 30, (const bf16_t*)(ws + WS_WRT) + (size_t)layer * 128 * 3072, 3072, 0, 16, lds, E); }
    LAS unsigned* hist = (LAS unsigned*)(lds + RT_OFF); LAS unsigned* gbase = hist + 64;
    if (tid < 64) hist[tid] = 0u;
    __syncthreads();
    unsigned* cnt = (unsigned*)(ws + WS_CTL) + CW_CNT + 2048 * layer;
    int* list = (int*)(ws + WS_LIST);
    const bool act = tid < ROWS; const int tok = m0 + tid;
    int ea = 0, eb = 0; float w1 = 0.f, w2 = 0.f; unsigned la = 0, lb = 0;
    if (act) {
        LAS float* l = lg + tid * LGP;
        int g = 0; float gm = l[0];
#pragma unroll
        for (int j = 1; j < 8; ++j) if (l[j] > gm) { gm = l[j]; g = j; }
        float gs = 0.f;
#pragma unroll
        for (int j = 0; j < 8; ++j) gs += __expf(l[j] - gm);
        const float gate = 1.0f / gs;
        float el[8];
#pragma unroll
        for (int j = 0; j < 8; ++j) el[j] = l[8 + 8 * g + j];
        int i1 = 0; float m1 = el[0];
#pragma unroll
        for (int j = 1; j < 8; ++j) if (el[j] > m1) { m1 = el[j]; i1 = j; }
        int i2 = -1; float m2 = -3.0e38f;
#pragma unroll
        for (int j = 0; j < 8; ++j) if (j != i1 && el[j] > m2) { m2 = el[j]; i2 = j; }
        const float e2 = __expf(m2 - m1); w1 = gate / (1.0f + e2); w2 = gate * e2 / (1.0f + e2);
        ea = g * 8 + i1; eb = g * 8 + i2;
        la = __hip_atomic_fetch_add(&hist[ea], 1u, __ATOMIC_RELAXED, __HIP_MEMORY_SCOPE_WORKGROUP);
        lb = __hip_atomic_fetch_add(&hist[eb], 1u, __ATOMIC_RELAXED, __HIP_MEMORY_SCOPE_WORKGROUP);
    }
    __syncthreads();
    if (tid < 64) { const unsigned c = hist[tid]; gbase[tid] = c ? atomicAdd(&cnt[tid * 32], c) : 0u; }
    __syncthreads();
    if (act) {
        const unsigned pa = gbase[ea] + la, pb = gbase[eb] + lb;
        list[(size_t)ea * MOE_CAP + pa] = tok; list[(size_t)eb * MOE_CAP + pb] = tok;
        ((u32x4*)(ws + WS_TIE))[tok] = (u32x4){((unsigned)ea << 16) | pa, ((unsigned)eb << 16) | pb, __float_as_uint(w1), __float_as_uint(w2)};
    }
    __syncthreads();
}
namespace pg8 {
constexpr int BM = 256, BK = 64, HALF = 128, HTB = HALF * BK * 2;
DEV int lds_byte(int r, int c) { const int st = (r >> 4) * 2 + (c >> 5), rr = r & 15, cc = c & 31, ob = rr * 64 + cc * 2; return st * 1024 + (ob ^ (((ob >> 9) & 1) << 5)); }
DEV void stage_rc(int b, int& R, int& C) { const int st = b / 1024, sb = b % 1024, swz = sb ^ (((sb >> 9) & 1) << 5); R = (st >> 1) * 16 + swz / 64; C = (st & 1) * 32 + (swz % 64) / 2; }
DEV int perm32p(int rho) { const int n = rho >> 4, i = rho & 15; return 8 * (i >> 2) + 4 * n + (i & 3); }
struct Unit { int pm, pn; int arow, brow; int ridx, nvalid; };
struct Gemm { const void* A; const void* Bt; const int* LIST; int lda, ldb, K; };
typedef f32x4 Acc[2][2][4][2];

template <bool GATHER, class Epi, class Sched, bool FP8 = false>
DEV void gemm_phase(LAS char* lds, const Gemm g, const Sched& S, const Epi& E) {
    const int tid = otid(), wid = __builtin_amdgcn_readfirstlane(tid >> 6), lane = tid & 63, wr = wid >> 2, wc = wid & 3, fr = lane & 15, fq = lane >> 4;
    int nt = g.K / 128; asm volatile("" : "+s"(nt));
    int Rr[2], Cc[2];
    unsigned vB[2], vA[2][2];
#pragma unroll
    for (int i = 0; i < 2; ++i) { stage_rc(tid * 16 + i * 8192, Rr[i], Cc[i]); const int Rb = 64 * (Rr[i] >> 5) + (Epi::PERM ? perm32p(Rr[i] & 31) : (Rr[i] & 31));
        vB[i] = (unsigned)(Rb * g.ldb + Cc[i] * 2); vA[0][i] = (unsigned)(Rr[i] * g.lda + Cc[i] * 2); vA[1][i] = (unsigned)((Rr[i] + HALF) * g.lda + Cc[i] * 2); }
#define PG8_GOFF(u_, dst_, hh_) do { if (GATHER) { int r0_, c0_; stage_rc(otid() * 16, r0_, c0_); \
        _Pragma("unroll") for (int i_ = 0; i_ < 2; ++i_) { const int r_ = (hh_) * HALF + i_ * 64 + r0_; \
        const int gr_ = g.LIST[(u_).ridx + (r_ < (u_).nvalid ? r_ : 0)]; dst_[hh_][i_] = (unsigned)gr_ * (unsigned)g.lda + (unsigned)(c0_ * 2); } } } while (0)
    const size_t kstep = (size_t)(BK * 2);
    const size_t hstepB = (size_t)32 * g.ldb;
    const unsigned ldsw = (unsigned)wid * 1024u;
    const unsigned ldsb = (unsigned)(size_t)lds + ldsw;
    const size_t dA1 = (size_t)64 * g.lda, dA2 = (size_t)128 * g.lda;
    const size_t dB1 = (size_t)128 * g.ldb;
    const int aoff = lds_byte(wr * 64 + fr, fq * 8), boff = lds_byte(wc * 32 + fr, fq * 8);
#define PG8_SA(b, h) (((b) * 2 + (h)) * HTB)
#define PG8_SB(b, h) ((4 + (b) * 2 + (h)) * HTB)
#define PG8_STAGE2(bufoff, gbase, v0_, v1_) do { if (FP8) { glds16s((gbase), (v0_), ldsb + (unsigned)(bufoff)); glds16s((gbase), (v1_), ldsb + (unsigned)(bufoff) + 8192u); } else { \
        __builtin_amdgcn_global_load_lds((const unsigned*)((const char*)(gbase) + (v0_)), (LAS unsigned*)(lds + (bufoff) + ldsw), 16, 0, 0); \
        __builtin_amdgcn_global_load_lds((const unsigned*)((const char*)(gbase) + (v1_)), (LAS unsigned*)(lds + (bufoff) + ldsw + 8192), 16, 0, 0); } } while (0)
#define PG8_STAGE_B(bufoff, gbase) do { if (FP8) { glds16s((gbase), vB[0], ldsb + (unsigned)(bufoff)); glds16s((gbase) + dB1, vB[0], ldsb + (unsigned)(bufoff) + 8192u); } \
        else PG8_STAGE2(bufoff, gbase, vB[0], vB[1]); } while (0)
#define PG8_STAGE_A(bufoff, gbase, hh, nx) do { if (FP8 && !GATHER) { glds16s((gbase) + (size_t)(hh) * dA2, vA[0][0], ldsb + (unsigned)(bufoff)); glds16s((gbase) + (size_t)(hh) * dA2 + dA1, vA[0][0], ldsb + (unsigned)(bufoff) + 8192u); } \
        else PG8_STAGE2(bufoff, gbase, vA[hh][0], vA[hh][1]); } while (0)
#define PG8_LD8(p_) __builtin_shufflevector(*(const LAS i32x4*)(p_), *(const LAS i32x4*)((p_) + 1024), 0, 1, 2, 3, 4, 5, 6, 7)
#define PG8_LDA(dst, b, h) do { if (FP8) { _Pragma("unroll") for (int m = 0; m < 4; ++m) dst##8[m] = PG8_LD8(lds + PG8_SA(b, h) + aoff + m * 2048); } else { \
        _Pragma("unroll") for (int m = 0; m < 4; ++m) _Pragma("unroll") for (int k = 0; k < 2; ++k) dst[m][k] = *(const LAS bf16x8*)(lds + PG8_SA(b, h) + aoff + m * 2048 + k * 1024); } } while (0)
#define PG8_LDB(dst, b, h) do { if (FP8) { _Pragma("unroll") for (int n = 0; n < 2; ++n) dst##8[n] = PG8_LD8(lds + PG8_SB(b, h) + boff + n * 2048); } else { \
        _Pragma("unroll") for (int n = 0; n < 2; ++n) _Pragma("unroll") for (int k = 0; k < 2; ++k) dst[n][k] = *(const LAS bf16x8*)(lds + PG8_SB(b, h) + boff + n * 2048 + k * 1024); } } while (0)
#define PG8_MMA(ai, bj, At, Bt) do { __builtin_amdgcn_s_setprio(1); _Pragma("unroll") for (int m = 0; m < 4; ++m) _Pragma("unroll") for (int n = 0; n < 2; ++n) _Pragma("unroll") for (int k = 0; k < 2; ++k) \
        acc[ai][bj][m][n] = __builtin_amdgcn_mfma_f32_16x16x32_bf16(Bt[n][k], At[m][k], acc[ai][bj][m][n], 0, 0, 0); __builtin_amdgcn_s_setprio(0); } while (0)
#define PG8_MMA8(ai, bj, At, Bt) do { __builtin_amdgcn_s_setprio(1); _Pragma("unroll") for (int m = 0; m < 4; ++m) _Pragma("unroll") for (int n = 0; n < 2; ++n) \
        acc[ai][bj][m][n] = __builtin_amdgcn_mfma_scale_f32_16x16x128_f8f6f4(Bt##8[n], At##8[m], acc[ai][bj][m][n], 0, 0, 0, 0x7a7a7a7a, 0, 0x7f7f7f7f); __builtin_amdgcn_s_setprio(0); } while (0)
#define PG8_MM(ai, bj, At, Bt) do { if (FP8) PG8_MMA8(ai, bj, At, Bt); else PG8_MMA(ai, bj, At, Bt); } while (0)
#define PG8_WAIT_V(n) asm volatile("s_waitcnt vmcnt(" #n ")" ::: "memory")
#define PG8_WAIT_L(n) asm volatile("s_waitcnt lgkmcnt(" #n ")" ::: "memory")
#define PG8_BAR __builtin_amdgcn_s_barrier()
#define PG8_SCHED __builtin_amdgcn_sched_barrier(0)
    Unit cur, nxt; int ui = 0;
    if (!S.next(0, cur)) return;
    f32x4 acc[2][2][4][2];
#pragma unroll
    for (int a = 0; a < 2; ++a)
#pragma unroll
        for (int b = 0; b < 2; ++b)
#pragma unroll
            for (int m = 0; m < 4; ++m)
#pragma unroll
                for (int n = 0; n < 2; ++n) acc[a][b][m][n] = (f32x4){0.f, 0.f, 0.f, 0.f};
    bf16x8 At[4][2], B0[2][2], B1[2][2]; v8i At8[4], B08[2], B18[2];
    PG8_GOFF(cur, vA, 0); PG8_GOFF(cur, vA, 1);
    const char* cA = (const char*)g.A + (GATHER ? (size_t)0 : (size_t)cur.arow * g.lda); const char* cB = (const char*)g.Bt + (size_t)cur.brow * g.ldb;
    PG8_STAGE_B(PG8_SB(0, 0), cB); PG8_STAGE_B(PG8_SB(0, 1), cB + hstepB); PG8_STAGE_A(PG8_SA(0, 0), cA, 0, false); PG8_STAGE_A(PG8_SA(0, 1), cA, 1, false);
    if (wr == 1) PG8_BAR;
    PG8_WAIT_V(2); PG8_BAR;
    PG8_STAGE_B(PG8_SB(1, 0), cB + kstep); PG8_STAGE_A(PG8_SA(1, 0), cA + kstep, 0, false); PG8_STAGE_B(PG8_SB(1, 1), cB + hstepB + kstep);
    PG8_WAIT_V(6); PG8_BAR;
    for (;;) {
        const bool has_next = S.next(ui + 1, nxt);
        const char* nA = has_next ? (const char*)g.A + (GATHER ? (size_t)0 : (size_t)nxt.arow * g.lda) : cA; const char* nB = has_next ? (const char*)g.Bt + (size_t)nxt.brow * g.ldb : cB;
        for (int t = 0; t < nt; t += 2) {
            const bool last = (t == nt - 2), lastn = last && has_next;
            const char* a1 = cA + (size_t)(t + 1) * kstep;
            const char* a2 = last ? nA : cA + (size_t)(t + 2) * kstep; const char* b2 = last ? nB : cB + (size_t)(t + 2) * kstep;
            const char* a3 = a2 + kstep; const char* b3 = b2 + kstep;
            if (GATHER && lastn) PG8_GOFF(nxt, vA, 0);
            PG8_LDB(B0, 0, 0); PG8_LDB(B1, 0, 1); PG8_SCHED; PG8_LDA(At, 0, 0); PG8_STAGE_A(PG8_SA(1, 1), a1, 1, false);
            if (GATHER && lastn) PG8_GOFF(nxt, vA, 1);
            PG8_WAIT_V(8); PG8_WAIT_L(0); PG8_BAR; PG8_MM(0, 0, At, B0); PG8_MM(0, 1, At, B1); PG8_BAR; PG8_SCHED;
            PG8_LDA(At, 0, 1); PG8_STAGE_B(PG8_SB(0, 0), b2); PG8_STAGE_B(PG8_SB(0, 1), b2 + hstepB); PG8_STAGE_A(PG8_SA(0, 0), a2, 0, lastn);
            PG8_WAIT_V(8); PG8_WAIT_L(0); PG8_BAR; PG8_MM(1, 0, At, B0); PG8_MM(1, 1, At, B1); PG8_BAR; PG8_SCHED;
            PG8_LDB(B0, 1, 0); PG8_LDB(B1, 1, 1); PG8_SCHED; PG8_LDA(At, 1, 0); PG8_STAGE_A(PG8_SA(0, 1), a2, 1, lastn);
            PG8_WAIT_V(8); PG8_WAIT_L(0); PG8_BAR; PG8_MM(0, 0, At, B0); PG8_MM(0, 1, At, B1); PG8_BAR; PG8_SCHED;
            PG8_LDA(At, 1, 1); PG8_STAGE_B(PG8_SB(1, 0), b3); PG8_STAGE_B(PG8_SB(1, 1), b3 + hstepB); PG8_STAGE_A(PG8_SA(1, 0), a3, 0, lastn);
            PG8_WAIT_V(8); PG8_WAIT_L(0); PG8_BAR; PG8_MM(1, 0, At, B0); PG8_MM(1, 1, At, B1); PG8_BAR; PG8_SCHED;
        }
        if (wr == 0) PG8_BAR;
        { const int l2 = otid(); E(acc, cur, wr, wc, l2 & 15, (l2 >> 4) & 3); }
        if (!has_next) break;
#pragma unroll
        for (int a = 0; a < 2; ++a)
#pragma unroll
            for (int b = 0; b < 2; ++b)
#pragma unroll
                for (int m = 0; m < 4; ++m)
#pragma unroll
                    for (int n = 0; n < 2; ++n) acc[a][b][m][n] = (f32x4){0.f, 0.f, 0.f, 0.f};
        cur = nxt; cA = nA; cB = nB; ++ui;
        if (wr == 1) PG8_BAR;
    }
    PG8_WAIT_V(0);
    PG8_BAR;
#undef PG8_GOFF
#undef PG8_SA
#undef PG8_SB
#undef PG8_STAGE2
#undef PG8_STAGE_A
#undef PG8_STAGE_B
#undef PG8_LDA
#undef PG8_LD8
#undef PG8_LDB
#undef PG8_MMA
#undef PG8_MMA8
#undef PG8_MM
#undef PG8_WAIT_V
#undef PG8_WAIT_L
#undef PG8_BAR
#undef PG8_SCHED
}
}


struct EpiInP { static constexpr bool PERM = true; const Params* p; int layer;
    DEV void operator()(const pg8::Acc& acc, const pg8::Unit& u, int wr, int wc, int fr, int fq) const {
        unsigned char* ws = p->ws; const int cb = u.pn * 256 + wc * 64;
#pragma unroll
        for (int ai = 0; ai < 2; ++ai)
#pragma unroll
        for (int m = 0; m < 4; ++m) {
            const int tok = u.pm * 256 + ai * 128 + wr * 64 + m * 16 + fr; int b, kidx; tok_info(tok, b, kidx);
            float x[2][8];
#pragma unroll
            for (int bj = 0; bj < 2; ++bj)
#pragma unroll
                for (int n = 0; n < 2; ++n)
#pragma unroll
                    for (int j = 0; j < 4; ++j) x[bj][4 * n + j] = acc[ai][bj][m][n][j];
            if (cb < 512) {
                bf16_t* dst = (bf16_t*)(ws + WS_ZA) + (size_t)tok * 512 + cb + 8 * fq;
#pragma unroll
                for (int bj = 0; bj < 2; ++bj) { float y[8];
#pragma unroll
                    for (int e = 0; e < 8; ++e) y[e] = gelu_tanh(x[bj][e]);
                    *(u32x4*)(dst + 32 * bj) = (u32x4){cvtpk(y[0], y[1]), cvtpk(y[2], y[3]), cvtpk(y[4], y[5]), cvtpk(y[6], y[7])}; }
            } else if (cb < 1664) {
                const int sect = (cb - 512) / 384, hd = ((cb - 512) % 384) >> 6;
                if (sect == 2) {
                    unsigned char* img = ws + WS_KVB + ((size_t)((b * 6 + hd) * 260 + (kidx >> 6))) * 16384 + 8192 + (kidx & 63) * 64;
#pragma unroll
                    for (int bj = 0; bj < 2; ++bj)
#pragma unroll
                        for (int n = 0; n < 2; ++n) { const u32x2 w = {cvtpk(x[bj][4 * n], x[bj][4 * n + 1]), cvtpk(x[bj][4 * n + 2], x[bj][4 * n + 3])};
                            *(u32x2*)(img + bj * 4096 + (16 * (fq & 1) + 8 * n + 4 * (fq >> 1)) * 2) = w; }
                } else {
                    float ss = 0.f;
#pragma unroll
                    for (int bj = 0; bj < 2; ++bj)
#pragma unroll
                        for (int e = 0; e < 8; ++e) ss += x[bj][e] * x[bj][e];
                    ss += lx16(ss); ss = half_sum(ss);
                    const float rinv = fast_rsq(ss * (1.0f / 64.0f) + EPS);
                    const float* gain = (sect == 0 ? p->b_q_norm : p->b_k_norm) + layer * 64;
                    const float sc = rinv * (sect == 0 ? 0.125f * LOG2E : 1.0f);
#pragma unroll
                    for (int bj = 0; bj < 2; ++bj) { const f32x4 g0 = *(const f32x4*)(gain + 32 * bj + 8 * fq), g1 = *(const f32x4*)(gain + 32 * bj + 8 * fq + 4); float y[8];
#pragma unroll
                        for (int e = 0; e < 4; ++e) { y[e] = x[bj][e] * sc * g0[e]; y[4 + e] = x[bj][4 + e] * sc * g1[e]; }
                        const u32x4 w = {cvtpk(y[0], y[1]), cvtpk(y[2], y[3]), cvtpk(y[4], y[5]), cvtpk(y[6], y[7])};
                        if (sect == 0) *(u32x4*)((bf16_t*)(ws + WS_QB) + (size_t)tok * 384 + hd * 64 + 32 * bj + 8 * fq) = w;
                        else *(u32x4*)(ws + WS_KVB + ((size_t)((b * 6 + hd) * 260 + (kidx >> 6))) * 16384 + (4 * bj + fq) * 1024 + (kidx & 63) * 16) = w; }
                }
            } else {
                bf16_t* dst = (bf16_t*)(ws + WS_ZC) + (size_t)tok * 640 + (cb - 1664) + 8 * fq; float ss = 0.f;
#pragma unroll
                for (int bj = 0; bj < 2; ++bj) {
#pragma unroll
                    for (int e = 0; e < 8; ++e) ss += x[bj][e] * x[bj][e];
                    *(u32x4*)(dst + 32 * bj) = (u32x4){cvtpk(x[bj][0], x[bj][1]), cvtpk(x[bj][2], x[bj][3]), cvtpk(x[bj][4], x[bj][5]), cvtpk(x[bj][6], x[bj][7])}; }
                ss += lx16(ss); ss = half_sum(ss);
                if (fq == 0) ((float*)(ws + WS_SS))[(size_t)tok * 16 + ((cb - 1664) >> 6)] = ss;
            }
        }
    }
};
struct EpiOutP { static constexpr bool PERM = true; const Params* p; int layer;
    DEV void operator()(const pg8::Acc& acc, const pg8::Unit& u, int wr, int wc, int fr, int fq) const {
        unsigned char* ws = p->ws; bf16_t* X = (bf16_t*)(ws + WS_X);
        const int cb = u.pn * 256 + wc * 64 + 8 * fq;
        const float* g1 = (const float*)(ws + WS_MOD) + (size_t)layer * 3 * 6144 + mod_row(u.pm * 256) * 6144 + 2048 + cb;
        f32x4 gv[2][2];
#pragma unroll
        for (int bj = 0; bj < 2; ++bj)
#pragma unroll
            for (int n = 0; n < 2; ++n) gv[bj][n] = *(const f32x4*)(g1 + 32 * bj + 4 * n);
#pragma unroll
        for (int ai = 0; ai < 2; ++ai)
#pragma unroll
        for (int m = 0; m < 4; ++m) {
            const int tok = u.pm * 256 + ai * 128 + wr * 64 + m * 16 + fr;
            bf16_t* dst = X + (size_t)tok * 1024 + cb;
            float bv[2][8];
            if (layer == 0) { const float* base = p->x + (size_t)tok * 1024 + cb;
#pragma unroll
                for (int bj = 0; bj < 2; ++bj) { const f32x4 a0 = *(const f32x4*)(base + 32 * bj), a1 = *(const f32x4*)(base + 32 * bj + 4);
#pragma unroll
                    for (int j = 0; j < 4; ++j) { bv[bj][j] = a0[j]; bv[bj][4 + j] = a1[j]; } } }
            else {
#pragma unroll
                for (int bj = 0; bj < 2; ++bj) { const u32x4 a = *(const u32x4*)(dst + 32 * bj);
#pragma unroll
                    for (int e = 0; e < 4; ++e) { bv[bj][2 * e] = bflo(a[e]); bv[bj][2 * e + 1] = bfhi(a[e]); } } }
#pragma unroll
            for (int bj = 0; bj < 2; ++bj) { float o[8];
#pragma unroll
                for (int n = 0; n < 2; ++n)
#pragma unroll
                    for (int j = 0; j < 4; ++j) o[4 * n + j] = bv[bj][4 * n + j] + gv[bj][n][j] * acc[ai][bj][m][n][j];
                *(u32x4*)(dst + 32 * bj) = (u32x4){cvtpk(o[0], o[1]), cvtpk(o[2], o[3]), cvtpk(o[4], o[5]), cvtpk(o[6], o[7])}; }
        }
    }
};
struct EpiMoe1P { static constexpr bool PERM = true; unsigned char* HB;
    DEV void operator()(const pg8::Acc& acc, const pg8::Unit& u, int wr, int wc, int fr, int fq) const {
#pragma unroll
        for (int ai = 0; ai < 2; ++ai)
#pragma unroll
        for (int m = 0; m < 4; ++m) { const int row = u.pm * 256 + ai * 128 + wr * 64 + m * 16 + fr; float o[8];
#pragma unroll
            for (int n = 0; n < 2; ++n)
#pragma unroll
                for (int j = 0; j < 4; ++j) o[4 * n + j] = silu_f(acc[ai][0][m][n][j]) * acc[ai][1][m][n][j];
            *(u32x2*)(HB + (size_t)row * 512 + 32 * (4 * u.pn + wc) + 8 * fq) = (u32x2){pk_fp8x4(o[0], o[1], o[2], o[3]), pk_fp8x4(o[4], o[5], o[6], o[7])}; }
    }
};
struct EpiMoe2P { static constexpr bool PERM = true; bf16_t* YS;
    DEV void operator()(const pg8::Acc& acc, const pg8::Unit& u, int wr, int wc, int fr, int fq) const {
#pragma unroll
        for (int ai = 0; ai < 2; ++ai)
#pragma unroll
        for (int m = 0; m < 4; ++m) { const int row = u.pm * 256 + ai * 128 + wr * 64 + m * 16 + fr;
#pragma unroll
            for (int bj = 0; bj < 2; ++bj)
                *(u32x4*)(YS + (size_t)row * 1024 + u.pn * 256 + wc * 64 + 32 * bj + 8 * fq) = (u32x4){cvtpk(acc[ai][bj][m][0][0], acc[ai][bj][m][0][1]), cvtpk(acc[ai][bj][m][0][2], acc[ai][bj][m][0][3]),
                                                                                                       cvtpk(acc[ai][bj][m][1][0], acc[ai][bj][m][1][1]), cvtpk(acc[ai][bj][m][1][2], acc[ai][bj][m][1][3])}; }
    }
};
constexpr int NARROW_PER = 2;
DEV bool xorder_in(int i, int& L, int vb) {
    const int G = gridDim.x;
    if (G & 7) return xorder(1170, i, L, vb);
    const int per = G >> 3, pe = per - NARROW_PER, chunk = (1170 + 7) >> 3, pos = vb % per;
    if (pos >= pe) return false;
    const int j = pos + pe * i;
    if (j >= chunk) return false;
    L = (vb / per) * chunk + j; return L < 1170;
}
struct SchedIn { int layer, vb;
    DEV bool next(int i, pg8::Unit& u) const { int L; if (!xorder_in(i, L, vb)) return false; int mt, nt; tile_of(L, 130, 9, mt, nt);
        u.pm = mt; u.pn = nt; u.arow = mt * 256; u.brow = layer * INWP + nt * 256; u.ridx = 0; u.nvalid = 0; return true; } };
struct SchedOut { int layer, vb;
    DEV bool next(int i, pg8::Unit& u) const { int L; if (!xorder(512, i, L, vb)) return false; int mt, nt; tile_of(L, 128, 4, mt, nt);
        u.pm = mt; u.pn = nt; u.arow = mt * 256; u.brow = layer * 1024 + nt * 256; u.ridx = 0; u.nvalid = 0; return true; } };
template <int WHICH> struct SchedMoe { int layer, vb, nitems; LAS int* bs; LAS int* cn;
    DEV bool next(int i, pg8::Unit& u) const { int it; if (!xorder(nitems, i, it, vb)) return false;
        const int rbi = it >> 2, nt = it & 3; int ex = 0; while (ex < 63 && bs[ex + 1] <= rbi) ++ex;
        const int rb = rbi - bs[ex];
        u.pm = rbi; u.pn = nt; u.arow = rbi * MOE_RB; u.brow = (layer * 64 + ex) * 1024 + nt * 256;
        if (WHICH == 0) { u.ridx = ex * MOE_CAP + rb * MOE_RB; u.nvalid = cn[ex] - rb * MOE_RB; } else { u.ridx = 0; u.nvalid = 0; }
        return true; } };

DEV void moe_tables(const Params& p, int layer, LAS int* bs, LAS int* cn) {
    const unsigned* cnt = (const unsigned*)(p.ws + WS_CTL) + CW_CNT + 2048 * layer;
    if (threadIdx.x == 0) { int a = 0; for (int e = 0; e < 64; ++e) { const int c = (int)cnt[e * 32]; cn[e] = c; bs[e] = a; a += (c + MOE_RB - 1) / MOE_RB; } bs[64] = a; }
    __syncthreads();
}
DEV void phase_moe_gemm(const Params& p, int layer, int which, LAS char* lds, int vb) {
    unsigned char* ws = ows_(p.ws);
    LAS int* bs = (LAS int*)(lds + LDS_MAIN - 1024); LAS int* cn = bs + 80;
    moe_tables(p, layer, bs, cn);
    const int nrb = bs[64], nitems = nrb * 4;
    if (which == 0) { pg8::Gemm g{ws + WS_H, ws + WS_W13, (const int*)(ws + WS_LIST), HLD * 2, 1024, 1024}; SchedMoe<0> S{layer, vb, nitems, bs, cn}; EpiMoe1P E{ws + WS_HB};
        pg8::gemm_phase<true, EpiMoe1P, SchedMoe<0>, true>(lds, g, S, E); }
    else { pg8::Gemm g{ws + WS_HB, ws + WS_W2, nullptr, 512, 512, 512}; SchedMoe<1> S{layer, vb, nitems, bs, cn}; EpiMoe2P E{(bf16_t*)(ws + WS_YS)};
        pg8::gemm_phase<false, EpiMoe2P, SchedMoe<1>, true>(lds, g, S, E); }
    __syncthreads();
}
DEV void phase_combine(const Params& p, int layer, LAS char* lds) {
    unsigned char* ws = ows_(p.ws);
    LAS int* bs = (LAS int*)(lds + LDS_MAIN - 1024); LAS int* cn = bs + 80;
    moe_tables(p, layer, bs, cn);
    const int tid = otid(), lane = tid & 63, gw = blockIdx.x * 8 + (tid >> 6), nw = gridDim.x * 8;
    const int ntok = layer == 0 ? NTOK : NLAT;
    const float* mod = (const float*)(ws + WS_MOD) + (size_t)layer * 3 * 6144;
    const float* modn = (const float*)(ws + WS_MOD) + (size_t)1 * 3 * 6144;
    const bf16_t* YS = (const bf16_t*)(ws + WS_YS);
    for (int tok0 = gw * 2; tok0 < ntok; tok0 += nw * 2) {
        float xv[2][2][8]; u32x4 ya[2][2], yb[2][2]; float w1[2], w2[2];
#pragma unroll
        for (int q = 0; q < 2; ++q) { const int tok = tok0 + q;
            const u32x4 ti = ((const u32x4*)(ws + WS_TIE))[tok];
            const int sa = bs[ti[0] >> 16] * MOE_RB + (int)(ti[0] & 0xffffu), sb = bs[ti[1] >> 16] * MOE_RB + (int)(ti[1] & 0xffffu);
            w1[q] = __uint_as_float(ti[2]); w2[q] = __uint_as_float(ti[3]);
            load_row_bf((const bf16_t*)(ws + WS_X) + (size_t)tok * 1024, xv[q], lane);
#pragma unroll
            for (int j = 0; j < 2; ++j) { const int col = 8 * lane + 512 * j; ya[q][j] = *(const u32x4*)(YS + (size_t)sa * 1024 + col); yb[q][j] = *(const u32x4*)(YS + (size_t)sb * 1024 + col); } }
#pragma unroll
        for (int q = 0; q < 2; ++q) { const int tok = tok0 + q;
            bf16_t* X = (bf16_t*)(ws + WS_X) + (size_t)tok * 1024;
            const float* g2 = mod + mod_row(tok) * 6144 + 5120;
#pragma unroll
            for (int j = 0; j < 2; ++j) { const int col = 8 * lane + 512 * j;
                const f32x4 ga = *(const f32x4*)(g2 + col), gb = *(const f32x4*)(g2 + col + 4);
#pragma unroll
                for (int e = 0; e < 4; ++e) { const float gg0 = e < 2 ? ga[2 * e] : gb[2 * e - 4], gg1 = e < 2 ? ga[2 * e + 1] : gb[2 * e - 3];
                    xv[q][j][2 * e] += gg0 * (w1[q] * bflo(ya[q][j][e]) + w2[q] * bflo(yb[q][j][e])); xv[q][j][2 * e + 1] += gg1 * (w1[q] * bfhi(ya[q][j][e]) + w2[q] * bfhi(yb[q][j][e])); }
                if (layer == 0) *(u32x4*)(X + col) = (u32x4){cvtpk(xv[q][j][0], xv[q][j][1]), cvtpk(xv[q][j][2], xv[q][j][3]), cvtpk(xv[q][j][4], xv[q][j][5]), cvtpk(xv[q][j][6], xv[q][j][7])};
                else { float* dst = p.out + (size_t)tok * 1024 + col;
                    *(f32x4*)dst = (f32x4){xv[q][j][0], xv[q][j][1], xv[q][j][2], xv[q][j][3]}; *(f32x4*)(dst + 4) = (f32x4){xv[q][j][4], xv[q][j][5], xv[q][j][6], xv[q][j][7]}; } }
            if (layer == 0) { const float* m = modn + mod_row(tok) * 6144; norm_store(p, tok, xv[q], p.norm_mix + 1024, m, m + 1024, false, lane); } }
    }
}

typedef const __attribute__((address_space(4))) Params* KParamsPtr;
DEV Params load_params() {
#if defined(__HIP_DEVICE_COMPILE__)
    KParamsPtr k = (KParamsPtr)__builtin_amdgcn_kernarg_segment_ptr(); asm volatile("" : "+s"(k));
    return *k;
#else
    return Params{};
#endif
}

constexpr int NPHASE = 1 + 2 * 11;
__global__ void __launch_bounds__(NTHREADS, 2) fwd(const Params p) {
    extern __shared__ __attribute__((aligned(16))) char lds_raw[];
    LAS char* lds = (LAS char*)lds_raw;
    unsigned char* ws0 = p.ws; const int bid = blockIdx.x, nb = gridDim.x;
    volatile LAS unsigned* xbw = (volatile LAS unsigned*)(lds + LDS_MAIN);
    if (threadIdx.x < 4) xbw[threadIdx.x] = 0u;
    __syncthreads();
    XcdBarrier bar; bar.bar = (unsigned*)(ws0 + WS_CTL); bar.x = 0; bar.st = xbw;
    const bool fused = (p.ph_hi - p.ph_lo) > 1;
    if (fused) bar = xcd_barrier_post((unsigned*)(ws0 + WS_CTL), xbw);
    int vb = bid;
    if (fused && threadIdx.x == 0) xbw[2] = xb_add((unsigned*)(ws0 + WS_CTL) + CW_XRANK + 64 * bar.x, 1u);
#define IN(k) (p.ph_lo <= (k) && (k) < p.ph_hi)
#define SEAM(k) do { if (fused && (k) + 1 < p.ph_hi) xcd_barrier(bar); } while (0)

    if (IN(0)) { const Params lp = load_params(); REP(0) phase_prologue(lp, lds); SEAM(0); }
    if (fused && p.ph_lo == 0) {
        if (threadIdx.x == 0) { unsigned pre = 0; for (unsigned j = 0; j < bar.x; ++j) pre += xb_ld((unsigned*)(ws0 + WS_CTL) + XB_XCNT(j)); xbw[3] = pre + xbw[2]; }
        __syncthreads();
        vb = (int)xbw[3]; if (vb >= nb) vb = bid;
    }
    for (int layer = 0; layer < 2; ++layer) {
        const int pb = 1 + layer * 11;
        if (IN(pb + 0)) { const Params lp = load_params(); unsigned char* ws = ows_(lp.ws); (void)ws; if (layer == 0) phase_norm(lp, 0, 0); SEAM(pb + 0); }
        if (IN(pb + 1)) { const Params lp = load_params(); unsigned char* ws = ows_(lp.ws); (void)ws;
            EpiIn E{&lp, layer};
            REP(2) {
                { pg8::Gemm g{ws + WS_H, ws + WS_WIN, nullptr, HLD * 2, 2048, 2048}; SchedIn S{layer, vb}; EpiInP EP{&lp, layer};
                  pg8::gemm_phase<false>(lds, g, S, EP); __syncthreads(); }
                if (nb & 7) { for (int u = (bid + 128) % nb; u < 130; u += nb)
                    gemm_unit<256, 64, 8, 1, 3>((const bf16_t*)(ws + WS_H), HLD, nullptr, 0, u * 256, 1 << 30, (const bf16_t*)(ws + WS_WIN) + (size_t)layer * INWP * 1024, 1024, 2304, 16, lds, E); }
                else { const int per = nb >> 3, pos = vb % per;
                    if (pos >= per - NARROW_PER) { Ring rg{0, 0}; const int q = (vb / per) * NARROW_PER + pos - (per - NARROW_PER), nq = 8 * NARROW_PER;
                        for (int u = q; u < 130; u += nq)
                            gemm_unit<256, 64, 8, 1, 3>((const bf16_t*)(ws + WS_H), HLD, nullptr, 0, u * 256, 1 << 30, (const bf16_t*)(ws + WS_WIN) + (size_t)layer * INWP * 1024, 1024, 2304, 16, lds, E, &rg, u + nq < 130, (u + nq) * 256, 2304); } } }
            SEAM(pb + 1);
        }
        if (IN(pb + 2)) { const Params lp = load_params(); unsigned char* ws = ows_(lp.ws); (void)ws;
            const int mtq = layer == 0 ? 130 : 128;
            { EpiQup E{&lp, layer};
              Ring rg{0, 0};
              REP(31) for (int i = 0;; ++i) { int u; if (!xorder(mtq * 3, i, u, vb)) break; const int mt = u / 3, nt = u % 3; int un = 0; const bool hn = xorder(mtq * 3, i + 1, un, vb);
                  gemm_unit<256, 192, 4, 2, 2>((const bf16_t*)(ws + WS_ZC), 640, nullptr, 0, mt * 256, 1 << 30, (const bf16_t*)(ws + WS_WQ) + (size_t)layer * 576 * 384, 384, nt * 192, 6, lds, E, &rg, hn, (un / 3) * 256, (un % 3) * 192); } }
            { EpiKVup E{&lp, layer};
              Ring rg{0, 0};
              REP(31) for (int i = 0;; ++i) { int u; if (!xorder(130 * 6, i, u, vb)) break; const int mt = u / 6, nt = u % 6; int un = 0; const bool hn = xorder(130 * 6, i + 1, un, vb);
                  gemm_unit<256, 128, 4, 2, 3, EpiKVup, false, 1>((const bf16_t*)(ws + WS_ZC) + 384, 640, nullptr, 0, mt * 256, 1 << 30, (const bf16_t*)(ws + WS_WKV) + (size_t)layer * 768 * 256, 256, nt * 128, 4, lds, E, &rg, hn, (un / 6) * 256, (un % 6) * 128); } }
            { const int nun = 768 + (layer == 0 ? 12 : 0);
              REP(32) for (int u = bid; u < nun; u += nb) { if (u < 768) { const int bh = u >> 6, rg = u & 63; na_unit(lp, layer, bh / 6, bh % 6, rg, false, lds); } else { const int bh = u - 768; na_unit(lp, layer, bh / 6, bh % 6, 0, true, lds); } } }
            { const int nch = layer == 0 ? 260 : 256;
              REP(33) for (int u = bid; u < nch; u += nb) gmlp_unit(lp, layer, u, lds); }
            SEAM(pb + 2);
        }
        if (IN(pb + 3)) { const Params lp = load_params(); unsigned char* ws = ows_(lp.ws); (void)ws;
            const int nun = 768 + (layer == 0 ? 12 : 0);
            SideJob sj; sj.g = 0; sj.le = 0; sj.j = bid; sj.v0 = (f32x4){0.f, 0.f, 0.f, 0.f}; sj.v1 = sj.v0; while (sj.j >= 384) { sj.j -= 384; ++sj.le; }
            const bool xg = (nb == 256);
            REP(4) for (int it = 0;; ++it) { int u;
                if (xg) { if (it < 3) u = (vb >> 5) * 96 + (vb & 31) + 32 * it; else if (it == 3 && vb < nun - 768) u = 768 + vb; else break; }
                else { u = bid + it * nb; if (u >= nun) break; }
                if (rep_ != 0) { if (u < 768) { const int bh = u >> 6, qb = u & 63; mla_unit<PROBE_MODE>(lp, layer, bh / 6, bh % 6, (bh / 6) * SEQ + qb * 256, 0, 130, lds, sj); } continue; }
                if (u < 768) { const int bh = u >> 6, qb = u & 63; mla_unit<0>(lp, layer, bh / 6, bh % 6, (bh / 6) * SEQ + qb * 256, 0, 130, lds, sj); }
                else { const int bh = u - 768; mla_unit<0>(lp, layer, bh / 6, bh % 6, NLAT + (bh / 6) * 256, 128, 130, lds, sj); } }
            while (sj.le < 64) { const SjDesc d = sj_desc(lp, layer, sj.le, sj.j);
                xpose_item(d.s0, d.s1, d.ld, d.ld, nullptr, (bf16_t*)d.dst, d.ld_dst, d.k0, d.nt, d.mode, (LAS float*)lds, true); sj_advance(sj); }
            SEAM(pb + 3);
        }
        if (IN(pb + 4)) { const Params lp = load_params(); unsigned char* ws = ows_(lp.ws); (void)ws;
            EpiOut E{&lp, layer}; const int nun = 512 + (layer == 0 ? 64 : 0);
            { pg8::Gemm g{ws + WS_MIX, ws + WS_WOUT, nullptr, 2048, 2048, 2048}; SchedOut S{layer, vb}; EpiOutP EP{&lp, layer};
              pg8::gemm_phase<false>(lds, g, S, EP); __syncthreads(); }
            for (int v = bid; v < nun - 512; v += nb) { const int mt = v >> 3, nt = v & 7;
                gemm_unit<64, 128, 2, 4, 3>((const bf16_t*)(ws + WS_MIX), 1024, nullptr, 0, NLAT + mt * 64, 1 << 30, (const bf16_t*)(ws + WS_WOUTP) + (size_t)layer * 1024 * 1024, 1024, nt * 128, 16, lds, E); }
            SEAM(pb + 4);
        }
        if (IN(pb + 5)) { const Params lp = load_params(); unsigned char* ws = ows_(lp.ws); (void)ws;
            for (int u = bid; u < 256; u += nb) ffn_front_unit<128>(lp, layer, u * 128, lds);
            if (layer == 0) for (int u = (bid + 128) % nb; u < 8; u += nb) ffn_front_unit<64>(lp, layer, NLAT + u * 64, lds);
            SEAM(pb + 5);
        }
        if (IN(pb + 8)) { const Params lp = load_params(); unsigned char* ws = ows_(lp.ws); (void)ws; REP(9) phase_moe_gemm(lp, layer, 0, lds, vb); SEAM(pb + 8); }
        if (IN(pb + 9)) { const Params lp = load_params(); unsigned char* ws = ows_(lp.ws); (void)ws; REP(10) phase_moe_gemm(lp, layer, 1, lds, vb); SEAM(pb + 9); }
        if (IN(pb + 10)) { const Params lp = load_params(); unsigned char* ws = ows_(lp.ws); (void)ws; phase_combine(lp, layer, lds); SEAM(pb + 10); }
    }
#undef IN
#undef SEAM
}

extern "C" void kernel_launch(void* const* d_in, const int* in_sizes, int n_in, void* d_out, int out_size, void* d_ws, size_t ws_size, hipStream_t stream) {
    static int grid = 0;
    if (grid == 0) {
        if (n_in != 27 || ws_size < WS_END) { fprintf(stderr, "kernel_launch: need 27 inputs and %zu bytes of workspace (got %d, %zu)\n", (size_t)WS_END, n_in, ws_size); grid = -1; return; }
        int dev = 0, cus = 0, per_cu = 0;
        if (hipGetDevice(&dev) != hipSuccess || hipDeviceGetAttribute(&cus, hipDeviceAttributeMultiprocessorCount, dev) != hipSuccess) { grid = -1; return; }
        if (hipFuncSetAttribute((const void*)fwd, hipFuncAttributeMaxDynamicSharedMemorySize, LDS_BYTES) != hipSuccess) { fprintf(stderr, "kernel_launch: hipFuncSetAttribute failed\n"); grid = -1; return; }
        if (hipOccupancyMaxActiveBlocksPerMultiprocessor(&per_cu, (const void*)fwd, NTHREADS, LDS_BYTES) != hipSuccess || per_cu < 1) { fprintf(stderr, "kernel_launch: occupancy query says %d\n", per_cu); per_cu = 1; }
        (void)hipGetLastError();
        grid = cus;
    }
    if (grid < 0) return;
    (void)hipMemsetAsync((char*)d_ws + WS_CTL, 0, 65536, stream);
    Params p{};
    const float** pp = (const float**)&p;
    for (int i = 0; i < 27; ++i) pp[i] = (const float*)d_in[i];
    p.out = (float*)d_out; p.ws = (unsigned char*)d_ws;
#if N_LAUNCH_MODE == 1
    p.ph_lo = 0; p.ph_hi = NPHASE;
    hipLaunchKernelGGL(fwd, dim3(grid), dim3(NTHREADS), LDS_BYTES, stream, p);
#else
    for (int k = 0; k < NPHASE; ++k) {
        if (k == 12 || k == 7 || k == 8 || k == 18 || k == 19) continue;
        p.ph_lo = k; p.ph_hi = k + 1;
        hipLaunchKernelGGL(fwd, dim3(grid), dim3(NTHREADS), LDS_BYTES, stream, p);
    }
#endif
}
```

```cpp
#include <hip/hip_runtime.h>
#include <stdint.h>
#include <stdio.h>

#ifndef N_LAUNCH_MODE
#define N_LAUNCH_MODE 1
#endif

typedef unsigned short bf16_t;
typedef short bf16x8 __attribute__((ext_vector_type(8)));
typedef short v4i16_t __attribute__((ext_vector_type(4)));
typedef float f32x16 __attribute__((ext_vector_type(16)));
typedef _Float16 f16x8 __attribute__((ext_vector_type(8)));
typedef int v8i __attribute__((ext_vector_type(8)));
typedef int i32x4 __attribute__((ext_vector_type(4)));
typedef _Float16 f16x2 __attribute__((ext_vector_type(2)));
typedef float f32x4 __attribute__((ext_vector_type(4)));
typedef float f32x2 __attribute__((ext_vector_type(2)));
typedef __bf16 bf16v2 __attribute__((ext_vector_type(2)));
typedef unsigned u32x4 __attribute__((ext_vector_type(4)));
typedef unsigned u32x2 __attribute__((ext_vector_type(2)));
#ifndef DBL_PH
#define DBL_PH -1
#endif
#ifndef PROBE_MODE
#define PROBE_MODE 0
#endif
#define REP(x) for (int rep_ = 0; rep_ < ((DBL_PH) == (x) ? 2 : 1); ++rep_)
#define LAS __attribute__((address_space(3)))
#define DEV __device__ __forceinline__
#define MFMA(a, b, c) __builtin_amdgcn_mfma_f32_32x32x16_bf16((a), (b), (c), 0, 0, 0)
#define WAITV(n) asm volatile("s_waitcnt vmcnt(%0)" ::"n"(n) : "memory")
#define SBAR() do { asm volatile("s_waitcnt lgkmcnt(0)" ::: "memory"); __builtin_amdgcn_s_barrier(); asm volatile("" ::: "memory"); } while (0)

constexpr int DM = 1024, NLAT = 32768, NCTX = 512, NTOK = 33280, SEQ = 16384, CTXL = 256;
constexpr int INW = 2336, INWP = 2432;
constexpr float EPS = 1e-6f, LOG2E = 1.4426950408889634f;
constexpr int NTHREADS = 512;
constexpr int HLD = 2048 + 64;
constexpr int MOE_CAP = 33280;
constexpr int MOE_RB = 256;
constexpr int MOE_MAXROWS = (NTOK * 2 / MOE_RB + 64) * MOE_RB;

constexpr size_t al256(size_t x) { return (x + 255) & ~(size_t)255; }
constexpr size_t WS_CTL = 0;
constexpr size_t WS_MOD = 65536;
constexpr size_t WS_ROPE = WS_MOD + al256(2 * 3 * 6144 * 4);
constexpr size_t WS_SCAL = WS_ROPE + 16384;
constexpr size_t WS_WIN = WS_SCAL + 256;
constexpr size_t WS_WQ = WS_WIN + (size_t)2 * INWP * 1024 * 2;
constexpr size_t WS_WKV = WS_WQ + (size_t)2 * 576 * 384 * 2;
constexpr size_t WS_WOUT = WS_WKV + (size_t)2 * 768 * 256 * 2;
constexpr size_t WS_WOUTP = WS_WOUT + (size_t)2 * 1024 * 1024 * 2;
constexpr size_t WS_WRT = WS_WOUTP + (size_t)2 * 1024 * 1024 * 2;
constexpr size_t WS_WSP = WS_WRT + (size_t)2 * 128 * 3072 * 2;
constexpr size_t WS_W13 = WS_WSP + (size_t)2 * 4 * 128 * 128 * 2;
constexpr size_t WS_W2 = WS_W13 + (size_t)2 * 64 * 1024 * 1024 * 2;
constexpr size_t WS_X = WS_W2 + (size_t)2 * 64 * 1024 * 512 * 2;
constexpr size_t WS_H = WS_X + (size_t)NTOK * 1024 * 4;
constexpr size_t WS_OVL = WS_H + (size_t)NTOK * HLD * 2;
constexpr size_t WS_ZA = WS_OVL;
constexpr size_t WS_ZC = WS_ZA + (size_t)NTOK * 512 * 2;
constexpr size_t WS_QB = WS_ZC + (size_t)NTOK * 640 * 2;
constexpr size_t WS_KVB = WS_QB + (size_t)NTOK * 384 * 2;
constexpr size_t WS_KR = WS_KVB + (size_t)2 * 6 * 260 * 16384;
constexpr size_t WS_SS = WS_KR + (size_t)NTOK * 32 * 2;
constexpr size_t WS_QC = WS_SS + (size_t)NTOK * 16 * 4;
constexpr size_t WS_KVC = WS_QC + (size_t)NTOK * 576 * 2;
constexpr size_t WS_MIX = WS_KVC + (size_t)2 * 6 * 130 * 40960;
constexpr size_t WS_MIXEND = WS_MIX + (size_t)NTOK * 1024 * 2;
constexpr size_t WS_LG = WS_OVL;
constexpr size_t WS_LIST = WS_LG + (size_t)NTOK * 128 * 4;
constexpr size_t WS_TIE = WS_LIST + (size_t)64 * MOE_CAP * 4;
constexpr size_t WS_HB = WS_TIE + (size_t)NTOK * 16;
constexpr size_t WS_YS = WS_HB + (size_t)MOE_MAXROWS * 512 * 2;
constexpr size_t WS_MOEEND = WS_YS + (size_t)MOE_MAXROWS * 1024 * 2;
constexpr size_t WS_END = (WS_MIXEND > WS_MOEEND ? WS_MIXEND : WS_MOEEND);

constexpr int MLA_KSUB = 8192, MLA_VOFF = 2 * MLA_KSUB, MLA_VSUB = 4096, MLA_IMG = MLA_VOFF + 2 * MLA_VSUB;
constexpr int CW_XRANK = 9216;
constexpr int CW_N1FLAG = 3520;
constexpr int CW_CNT = 4096;

constexpr int LDS_MAIN = 147456;
constexpr int LDS_BYTES = LDS_MAIN + 256;

struct Params {
    const float *x, *c, *ctx, *c_ctx, *w_ada, *b_ada, *norm_mix, *w_in, *a_v_norm, *a_w_s, *a_b_s, *b_q_norm, *b_k_norm, *b_rpb,
        *c_q_a_norm, *c_w_q_up, *c_kv_a_norm, *c_w_kv_up, *c_q_norm, *c_k_norm, *w_out, *norm_ffn, *moe_w_group, *moe_w_router,
        *moe_w1, *moe_w3, *moe_w2;
    float* out;
    unsigned char* ws;
    int ph_lo, ph_hi;
};

DEV int otid() { int t = threadIdx.x; asm volatile("" : "+v"(t)); return t; }
struct Params;
typedef __attribute__((address_space(1))) unsigned char* gptr_t;
DEV unsigned char* ows_(unsigned char* w) { gptr_t g = (gptr_t)w; asm volatile("" : "+s"(g)); return (unsigned char*)g; }
DEV unsigned cvtpk(float lo, float hi) { f32x2 v = {lo, hi}; bf16v2 r = __builtin_convertvector(v, bf16v2); return __builtin_bit_cast(unsigned, r); }
DEV unsigned cvtpk_h(float lo, float hi) { f32x2 v = {lo, hi}; f16x2 r = __builtin_convertvector(v, f16x2); return __builtin_bit_cast(unsigned, r); }
DEV unsigned pk_fp8x4(float a, float b, float c, float d) { int w = __builtin_amdgcn_cvt_pk_fp8_f32(a, b, 0, false); w = __builtin_amdgcn_cvt_pk_fp8_f32(c, d, w, true); return (unsigned)w; }
DEV u32x4 pk_fp8x16(const f32x16& v) { return (u32x4){pk_fp8x4(v[0], v[1], v[2], v[3]), pk_fp8x4(v[4], v[5], v[6], v[7]), pk_fp8x4(v[8], v[9], v[10], v[11]), pk_fp8x4(v[12], v[13], v[14], v[15])}; }
DEV float bflo(unsigned u) { return __uint_as_float(u << 16); }
DEV float bfhi(unsigned u) { return __uint_as_float(u & 0xffff0000u); }
DEV float bf2f(bf16_t b) { return __uint_as_float(((unsigned)b) << 16); }
DEV int crow(int i, int h) { return (i & 3) + 8 * (i >> 2) + 4 * h; }
DEV int perm32(int rho) { return 16 * ((rho >> 2) & 1) + 4 * (rho >> 3) + (rho & 3); }
DEV float fast_rcp(float x) { return __builtin_amdgcn_rcpf(x); }
DEV float fast_rsq(float x) { return __builtin_amdgcn_rsqf(x); }
DEV float ex2(float x) { return __builtin_amdgcn_exp2f(x); }
DEV float gelu_tanh(float x) { const float u2 = x * (1.5957691216057308f + 0.07135481627f * x * x); return x * fast_rcp(1.0f + ex2(-u2 * LOG2E)); }
DEV float silu_f(float a) { return a * fast_rcp(1.0f + ex2(-a * LOG2E)); }
template <int CTRL> DEV float dpp_mov(float v) { return __builtin_bit_cast(float, __builtin_amdgcn_update_dpp(0, __builtin_bit_cast(int, v), CTRL, 0xf, 0xf, true)); }
DEV float lx1(float v) { return dpp_mov<0xB1>(v); }
DEV float lx2(float v) { return dpp_mov<0x4E>(v); }
DEV float lr4(float v) { return dpp_mov<0x124>(v); }
DEV float lr8(float v) { return dpp_mov<0x128>(v); }
DEV float lx16(float v) { return __builtin_bit_cast(float, __builtin_amdgcn_ds_swizzle(__builtin_bit_cast(int, v), 0x401F)); }
DEV void swap32(float v, float& a, float& b) { a = v; b = v; asm volatile("s_nop 1\n\tv_permlane32_swap_b32 %0, %1\n\ts_nop 1" : "+v"(a), "+v"(b)); }
DEV u32x4 zero_u32x4() { unsigned z = 0u; asm volatile("" : "+v"(z)); return (u32x4){z, z, z, z}; }
DEV float half_sum(float v) { float a, b; swap32(v, a, b); return a + b; }
DEV float wave_sum(float v) { v = half_sum(v); v += lx16(v); v += lr8(v); v += lr4(v); v += lx2(v); v += lx1(v); return v; }
DEV float wave_max(float v) { float a, b; swap32(v, a, b); v = fmaxf(a, b); v = fmaxf(v, lx16(v)); v = fmaxf(v, lr8(v)); v = fmaxf(v, lr4(v)); v = fmaxf(v, lx2(v)); v = fmaxf(v, lx1(v)); return v; }
DEV void glds16(const void* g, LAS char* l) { __builtin_amdgcn_global_load_lds((const unsigned*)g, (LAS unsigned*)l, 16, 0, 0); }
DEV void glds16s(const void* sbase, unsigned voff, unsigned lds_base) { unsigned sv; asm volatile("s_mov_b32 %0, m0\n\ts_mov_b32 m0, %3\n\ts_nop 0\n\tglobal_load_lds_dwordx4 %1, %2\n\ts_mov_b32 m0, %0" : "=&s"(sv) : "v"(voff), "s"(sbase), "s"(lds_base) : "memory"); }
DEV void glds16a(const void* g, unsigned lds_base) { unsigned sv; asm volatile("s_mov_b32 %0, m0\n\ts_mov_b32 m0, %2\n\ts_nop 0\n\tglobal_load_lds_dwordx4 %1, off\n\ts_mov_b32 m0, %0" : "=&s"(sv) : "v"(g), "s"(lds_base) : "memory"); }
DEV unsigned lds_addr(LAS char* p) { return (unsigned)(uintptr_t)p; }
DEV bf16x8 lds_b128(LAS char* p) { return *(LAS bf16x8*)p; }
DEV v4i16_t lds_tr(LAS char* p) { return __builtin_amdgcn_ds_read_tr16_b64_v4i16((LAS v4i16_t*)p); }
DEV bf16x8 cat4(v4i16_t a, v4i16_t b) { return __builtin_shufflevector(a, b, 0, 1, 2, 3, 4, 5, 6, 7); }
DEV void tok_info(int tok, int& b, int& kidx) { if (tok < NLAT) { b = tok >> 14; kidx = tok & 16383; } else { const int j = tok - NLAT; b = j >> 8; kidx = 16384 + (j & 255); } }
DEV int mod_row(int tok) { return tok < NLAT ? (tok >> 14) : 2; }
DEV void pack16(const f32x16& v, u32x4& lo, u32x4& hi) {
    lo = (u32x4){cvtpk(v[0], v[1]), cvtpk(v[2], v[3]), cvtpk(v[4], v[5]), cvtpk(v[6], v[7])};
    hi = (u32x4){cvtpk(v[8], v[9]), cvtpk(v[10], v[11]), cvtpk(v[12], v[13]), cvtpk(v[14], v[15])};
}
DEV float sumsq16(const f32x16& v) { float s = 0.f;
#pragma unroll
    for (int i = 0; i < 16; ++i) s += v[i] * v[i];
    return s; }

#define XB_TMO      128
#define XB_XCNT(j)  (256  + 64 * (j))
#define XB_XSUB(j)  (1280 + 64 * (j))
#define XB_XGEN(j)  (2304 + 64 * (j))
#define XB_TOP      3328
#define XB_TOPGEN   3392
#define XCD_BAR_WORDS 3456
#define XB_SPIN_CAP (1u << 22)
DEV unsigned xb_ld(unsigned* p)              { return __hip_atomic_load(p, __ATOMIC_RELAXED, __HIP_MEMORY_SCOPE_AGENT); }
DEV unsigned xb_add(unsigned* p, unsigned v) { return __hip_atomic_fetch_add(p, v, __ATOMIC_RELAXED, __HIP_MEMORY_SCOPE_AGENT); }
DEV unsigned xb_xcc_id() { return (unsigned)__builtin_amdgcn_s_getreg((3 << 11) | 20) & 0xFu; }
#define XB_SPIN(cond, bar) do { unsigned _sp = 0; while (cond) { __builtin_amdgcn_s_sleep(1); \
    if ((++_sp & 255u) == 0u) { if (xb_ld(&(bar)[XB_TMO])) break; if (_sp > XB_SPIN_CAP) { atomicAdd(&(bar)[XB_TMO], 1u); break; } } } } while (0)
struct XcdBarrier { unsigned* bar; unsigned x; volatile LAS unsigned* st; };
DEV XcdBarrier xcd_barrier_post(unsigned* bar, volatile LAS unsigned* st) {
    XcdBarrier b; b.bar = bar; b.x = xb_xcc_id(); b.st = st;
    if (threadIdx.x == 0) (void)xb_add(&bar[XB_XCNT(b.x)], 1u);
    return b;
}
DEV void xcd_barrier_complete(unsigned* bar, unsigned x, unsigned& nloc, unsigned& nx) {
    const unsigned G = gridDim.x * gridDim.y * gridDim.z;
    unsigned sum, cnt, mine, sp = 0u;
    for (;;) {
        sum = 0u; cnt = 0u; mine = 0u;
#pragma unroll
        for (unsigned j = 0; j < 16; ++j) { const unsigned c = xb_ld(&bar[XB_XCNT(j)]); sum += c; cnt += (c > 0u) ? 1u : 0u; mine = (j == x) ? c : mine; }
        if (sum == G) break;
        __builtin_amdgcn_s_sleep(1);
        if ((++sp & 255u) == 0u) { if (xb_ld(&bar[XB_TMO])) break; if (sp > XB_SPIN_CAP) { atomicAdd(&bar[XB_TMO], 1u); break; } }
    }
    nloc = mine > 0u ? mine : 1u; nx = cnt > 0u ? cnt : 1u;
}
DEV void xcd_barrier(const XcdBarrier& b) {
    asm volatile("s_waitcnt vmcnt(0)" ::: "memory");
    __syncthreads();
    if (threadIdx.x == 0) {
        unsigned* bar = b.bar;
        __builtin_amdgcn_s_waitcnt(0);
        unsigned nloc = b.st[0], nx = b.st[1];
        if (nloc == 0u) { xcd_barrier_complete(bar, b.x, nloc, nx); b.st[0] = nloc; b.st[1] = nx; }
        const unsigned old = xb_add(&bar[XB_XSUB(b.x)], 1u);
        const unsigned gen = old / nloc;
        if (old + 1u == (gen + 1u) * nloc) {
            __builtin_amdgcn_fence(__ATOMIC_RELEASE, "agent");
            asm volatile("s_waitcnt vmcnt(0)" ::: "memory");
            const unsigned og = xb_add(&bar[XB_TOP], 1u);
            const unsigned tg = og / nx;
            if (og + 1u == (tg + 1u) * nx) xb_add(&bar[XB_TOPGEN], 1u);
            else XB_SPIN(xb_ld(&bar[XB_TOPGEN]) == tg, bar);
            __builtin_amdgcn_fence(__ATOMIC_ACQUIRE, "agent");
            xb_add(&bar[XB_XGEN(b.x)], 1u);
            asm volatile("s_waitcnt vmcnt(0)" ::: "memory");
        } else {
            XB_SPIN(xb_ld(&bar[XB_XGEN(b.x)]) == gen, bar);
            __builtin_amdgcn_fence(__ATOMIC_ACQUIRE, "agent");
            asm volatile("s_waitcnt vmcnt(0)" ::: "memory");
        }
    }
    __syncthreads();
}

DEV bool xorder(int U, int i, int& L, int vb) {
    const int G = gridDim.x;
    if (G & 7) { L = vb + G * i; return L < U; }
    const int per = G >> 3, chunk = (U + 7) >> 3, j = (vb % per) + per * i;
    if (j >= chunk) return false;
    L = (vb / per) * chunk + j; return L < U;
}
DEV void tile_of(int L, int nM, int nN, int& mt, int& nt) { const int g = L / (8 * nN), rem = L - g * 8 * nN, gsz = min(8, nM - 8 * g); mt = 8 * g + rem % gsz; nt = rem / gsz; }

struct Ring { int st, primed; };
template <int BM, int BN, int WM, int WN, int NST, class Epi, bool F16 = false, int SWAPWN = -1>
DEV void gemm_unit(const bf16_t* __restrict__ A, int lda, const int* __restrict__ rowidx, int nvalid, int m0, int a_wrap,
                   const bf16_t* __restrict__ Bt, int ldb, int n0, int nk, LAS char* lds, const Epi& epi, Ring* ring = nullptr, bool has_next = false, int m0n = 0, int n0n = 0) {
    constexpr int TM = BM / (WM * 32), TN = BN / (WN * 32);
    constexpr int AB = BM * 128, BB = BN * 128, STG = AB + BB, NLA = AB / 8192, NLB = BB / 8192, NL = NLA + NLB;
    static_assert(STG * NST <= LDS_MAIN, "LDS");
    const int tid = otid(), lane = tid & 63, wid = tid >> 6, r = lane & 31, h = lane >> 5;
    const int wm = wid / WN, wn = wid % WN;
    const bool swapped = SWAPWN >= 0 && __builtin_amdgcn_readfirstlane(wn) == SWAPWN;
    const int lrow = tid >> 3, lc = (tid & 7) ^ ((lrow >> 1) & 7);
    unsigned aoff[NLA], boff[NLB];
#pragma unroll
    for (int i = 0; i < NLA; ++i) { const int row = i * 64 + lrow; int grow;
        if (rowidx) grow = rowidx[row < nvalid ? row : 0]; else grow = m0 + row;
        aoff[i] = (unsigned)grow * (unsigned)lda + lc * 8; }
#pragma unroll
    for (int i = 0; i < NLB; ++i) boff[i] = (unsigned)(n0 + i * 64 + lrow) * (unsigned)ldb + lc * 8;
    unsigned aoffn[NLA], boffn[NLB];
    if (ring) {
#pragma unroll
        for (int i = 0; i < NLA; ++i) aoffn[i] = (unsigned)(m0n + i * 64 + lrow) * (unsigned)lda + lc * 8;
#pragma unroll
        for (int i = 0; i < NLB; ++i) boffn[i] = (unsigned)(n0n + i * 64 + lrow) * (unsigned)ldb + lc * 8; }
    const int sw = (r >> 1) & 7;
    unsigned koff[4];
#pragma unroll
    for (int ks = 0; ks < 4; ++ks) koff[ks] = (unsigned)(((2 * ks + h) ^ sw) << 4);
    const unsigned arow = (unsigned)(wm * TM * 32 + r) * 128u, brow = (unsigned)AB + (unsigned)(wn * TN * 32 + r) * 128u;
    f32x16 acc[TM][TN];
#pragma unroll
    for (int a = 0; a < TM; ++a)
#pragma unroll
        for (int b = 0; b < TN; ++b)
#pragma unroll
            for (int i = 0; i < 16; ++i) acc[a][b][i] = 0.f;
#define GEMM_ISSUE(kt_, st_) do { int ka_ = (kt_) * 64; if (ka_ >= a_wrap) ka_ -= a_wrap; LAS char* sa_ = lds + (st_) * STG + tid * 16; \
    _Pragma("unroll") for (int i_ = 0; i_ < NLA; ++i_) glds16(A + aoff[i_] + ka_, sa_ + i_ * 8192); \
    _Pragma("unroll") for (int i_ = 0; i_ < NLB; ++i_) glds16(Bt + boff[i_] + (kt_) * 64, sa_ + AB + i_ * 8192); } while (0)
#define GEMM_ISSUE_N(kt_, st_) do { LAS char* sa_ = lds + (st_) * STG + tid * 16; \
    _Pragma("unroll") for (int i_ = 0; i_ < NLA; ++i_) glds16(A + aoffn[i_] + (kt_) * 64, sa_ + i_ * 8192); \
    _Pragma("unroll") for (int i_ = 0; i_ < NLB; ++i_) glds16(Bt + boffn[i_] + (kt_) * 64, sa_ + AB + i_ * 8192); } while (0)
    int st = ring ? ring->st : 0;
    if (NST > 3) {
#pragma unroll
        for (int q = 0; q < NST - 1; ++q) if (q < nk) GEMM_ISSUE(q, q); }
    else if (!(ring && ring->primed)) { GEMM_ISSUE(0, st); if (NST == 3 && nk > 1) GEMM_ISSUE(1, (st + 1 == NST) ? 0 : st + 1); }
    int stn = st + NST - 1; if (stn >= NST) stn -= NST;
    const bool stream_next = ring && has_next;
    for (int kt = 0; kt < nk; ++kt) {
        if (NST > 3) { const int yng = min(NST - 2, nk - 1 - kt);
            if (yng >= 4) WAITV(4 * NL); else if (yng == 3) WAITV(3 * NL); else if (yng == 2) WAITV(2 * NL); else if (yng == 1) WAITV(NL); else WAITV(0); }
        else if (NST == 3 && (kt + 1 < nk || stream_next)) WAITV(NL); else WAITV(0);
        SBAR();
        if (kt + NST - 1 < nk) GEMM_ISSUE(kt + NST - 1, stn); else if (stream_next) GEMM_ISSUE_N(kt + NST - 1 - nk, stn);
        LAS char* sb = lds + st * STG;
        if (SWAPWN >= 0 && swapped) {
#pragma unroll
        for (int ks = 0; ks < 4; ++ks) {
            bf16x8 af[TM], wf[TN];
#pragma unroll
            for (int a = 0; a < TM; ++a) af[a] = lds_b128(sb + arow + a * 4096 + koff[ks]);
#pragma unroll
            for (int b = 0; b < TN; ++b) wf[b] = lds_b128(sb + brow + b * 4096 + koff[ks]);
#pragma unroll
            for (int a = 0; a < TM; ++a)
#pragma unroll
                for (int b = 0; b < TN; ++b) acc[a][b] = MFMA(af[a], wf[b], acc[a][b]);
        } } else {
#pragma unroll
        for (int ks = 0; ks < 4; ++ks) {
            bf16x8 af[TM], wf[TN];
#pragma unroll
            for (int a = 0; a < TM; ++a) af[a] = lds_b128(sb + arow + a * 4096 + koff[ks]);
#pragma unroll
            for (int b = 0; b < TN; ++b) wf[b] = lds_b128(sb + brow + b * 4096 + koff[ks]);
#pragma unroll
            for (int a = 0; a < TM; ++a)
#pragma unroll
                for (int b = 0; b < TN; ++b) acc[a][b] = F16 ? __builtin_amdgcn_mfma_f32_32x32x16_f16(__builtin_bit_cast(f16x8, wf[b]), __builtin_bit_cast(f16x8, af[a]), acc[a][b], 0, 0, 0)
                                                            : MFMA(wf[b], af[a], acc[a][b]);
        } }
        st = (st + 1 == NST) ? 0 : st + 1; stn = (stn + 1 == NST) ? 0 : stn + 1;
    }
#undef GEMM_ISSUE
#undef GEMM_ISSUE_N
    if (ring) { ring->st = st; ring->primed = stream_next ? 1 : 0; }
    SBAR();
    epi.template run<TM, TN>(acc, m0 + wm * TM * 32, n0 + wn * TN * 32, r, h);
}

template <class Epi, int MODE = 0>
DEV void gemm256(const bf16_t* __restrict__ A, int lda, const int* __restrict__ rowidx, int nvalid, int m0, int a_wrap,
                 const bf16_t* __restrict__ Bt, int ldb, int n0, int nk, LAS char* lds, const Epi& epi) {
    constexpr int TM = 2, TN = 4, SLOT = 32768;
    const int tid = otid(), lane = tid & 63, wid = tid >> 6, r = lane & 31, h = lane >> 5;
    const int wm = wid & 3, wn = wid >> 2;
    const int lrow = tid >> 2, lc = (tid & 3) ^ ((lrow >> 2) & 3);
    unsigned aoff[2], boff[2];
#pragma unroll
    for (int i = 0; i < 2; ++i) { const int row = i * 128 + lrow; int grow;
        if (rowidx) grow = rowidx[row < nvalid ? row : 0]; else grow = m0 + row;
        aoff[i] = (unsigned)grow * (unsigned)lda + lc * 8; boff[i] = (unsigned)(n0 + row) * (unsigned)ldb + lc * 8; }
    const int swz = (r >> 2) & 3;
    const unsigned koff0 = (unsigned)((h ^ swz) << 4), koff1 = (unsigned)(((2 + h) ^ swz) << 4);
    const unsigned arow = (unsigned)(wm * 64 + r) * 64u, brow = 16384u + (unsigned)(wn * 128 + r) * 64u;
    f32x16 acc[TM][TN];
#pragma unroll
    for (int a = 0; a < TM; ++a)
#pragma unroll
        for (int b = 0; b < TN; ++b)
#pragma unroll
            for (int i = 0; i < 16; ++i) acc[a][b][i] = 0.f;
    const int nq = 2 * nk;
#define G2_ISSUE(q_) do { int ka_ = (q_) * 32; if (ka_ >= a_wrap) ka_ -= a_wrap; LAS char* s_ = lds + ((q_) & 3) * SLOT + tid * 16; \
    glds16(A + aoff[0] + ka_, s_); glds16(A + aoff[1] + ka_, s_ + 8192); glds16(Bt + boff[0] + (q_) * 32, s_ + 16384); glds16(Bt + boff[1] + (q_) * 32, s_ + 24576); } while (0)
    if (MODE != 2) { G2_ISSUE(0); G2_ISSUE(1); G2_ISSUE(2); }
    WAITV(8); SBAR();
    if (wn == 1) SBAR();
#define G2_PIECE(q_, i_) do { int ka_ = (q_) * 32; if (ka_ >= a_wrap) ka_ -= a_wrap; LAS char* s_ = lds + ((q_) & 3) * SLOT + tid * 16; \
    if ((i_) == 0) glds16(A + aoff[0] + ka_, s_); else if ((i_) == 1) glds16(A + aoff[1] + ka_, s_ + 8192); \
    else if ((i_) == 2) glds16(Bt + boff[0] + (q_) * 32, s_ + 16384); else glds16(Bt + boff[1] + (q_) * 32, s_ + 24576); } while (0)
    for (int q = 0; q < nq; ++q) {
        LAS char* sb = lds + (q & 3) * SLOT;
        bf16x8 af[2][TM], wf[2][TN];
        if (MODE != 3) {
#pragma unroll
        for (int a = 0; a < TM; ++a) { af[0][a] = lds_b128(sb + arow + a * 2048 + koff0); af[1][a] = lds_b128(sb + arow + a * 2048 + koff1); }
#pragma unroll
        for (int b = 0; b < TN; ++b) { wf[0][b] = lds_b128(sb + brow + b * 2048 + koff0); wf[1][b] = lds_b128(sb + brow + b * 2048 + koff1); }
        }
        if (q + 2 < nq) WAITV(4); else WAITV(0);
        SBAR();
        __builtin_amdgcn_sched_barrier(0);
        __builtin_amdgcn_s_setprio(1);
        const bool pre = (MODE != 2) && (q + 3 < nq);
#pragma unroll
        for (int ks = 0; ks < 2; ++ks)
#pragma unroll
            for (int a = 0; a < TM; ++a) {
#pragma unroll
                for (int b = 0; b < TN; ++b) if (MODE != 3) acc[a][b] = MFMA(wf[ks][b], af[ks][a], acc[a][b]);
                if (pre) G2_PIECE(q + 3, ks * 2 + a);
                __builtin_amdgcn_sched_barrier(0);
            }
        __builtin_amdgcn_s_setprio(0);
        __builtin_amdgcn_sched_barrier(0);
        SBAR();
    }
#undef G2_PIECE
#undef G2_ISSUE
    if (wn == 0) SBAR();
    if (MODE == 0) epi.template run<TM, TN>(acc, m0 + wm * 64, n0 + wn * 128, r, h);
    else if (acc[0][0][0] == 12345.678f) epi.template run<TM, TN>(acc, m0 + wm * 64, n0 + wn * 128, r, h);
}

struct EpiIn {
    const Params* p; int layer;
    template <int TM, int TN> DEV void run(const f32x16 (&accf)[TM][TN], int mw, int cbw, int r, int h) const {
        static_assert(TN % 2 == 0, "64-column groups");
        unsigned char* ws = p->ws;
#pragma unroll
        for (int g2 = 0; g2 < TN / 2; ++g2)
#pragma unroll
        for (int tm = 0; tm < TM; ++tm) { const int cb = cbw + 64 * g2; const f32x16 (&acc)[TM][TN] = accf; const int T0 = 2 * g2;
            const int tok = mw + tm * 32 + r; int b, kidx; tok_info(tok, b, kidx);
            if (cb < 512) {
                bf16_t* dst = (bf16_t*)(ws + WS_ZA) + (size_t)tok * 512 + cb + 16 * h;
#pragma unroll
                for (int tn = 0; tn < 2; ++tn) { f32x16 v = acc[tm][T0 + tn];
#pragma unroll
                    for (int i = 0; i < 16; ++i) v[i] = gelu_tanh(v[i]);
                    u32x4 lo, hi; pack16(v, lo, hi); *(u32x4*)(dst + tn * 32) = lo; *(u32x4*)(dst + tn * 32 + 8) = hi; }
            } else if (cb < 1664) {
                const int sect = (cb - 512) / 384, hd = ((cb - 512) % 384) >> 6;
                if (sect == 2) {
                    unsigned char* img = ws + WS_KVB + ((size_t)((b * 6 + hd) * 260 + (kidx >> 6))) * 16384 + 8192 + (kidx & 63) * 64;
#pragma unroll
                    for (int tn = 0; tn < 2; ++tn)
#pragma unroll
                        for (int g = 0; g < 4; ++g) { u32x2 w = {cvtpk(acc[tm][T0 + tn][4 * g], acc[tm][T0 + tn][4 * g + 1]), cvtpk(acc[tm][T0 + tn][4 * g + 2], acc[tm][T0 + tn][4 * g + 3])};
                            *(u32x2*)(img + tn * 4096 + (8 * g + 4 * h) * 2) = w; }
                } else {
                    float ss = half_sum(sumsq16(acc[tm][T0]) + sumsq16(acc[tm][T0 + 1]));
                    const float rinv = fast_rsq(ss * (1.0f / 64.0f) + EPS);
                    const float* gain = (sect == 0 ? p->b_q_norm : p->b_k_norm) + layer * 64;
                    const float sc = rinv * (sect == 0 ? 0.125f * LOG2E : 1.0f);
#pragma unroll
                    for (int tn = 0; tn < 2; ++tn) { f32x16 v;
                        const f32x4* gp = (const f32x4*)(gain + tn * 32 + 16 * h);
#pragma unroll
                        for (int q = 0; q < 4; ++q) { const f32x4 g4 = gp[q];
#pragma unroll
                            for (int j = 0; j < 4; ++j) v[4 * q + j] = acc[tm][T0 + tn][4 * q + j] * sc * g4[j]; }
                        u32x4 lo, hi; pack16(v, lo, hi);
                        if (sect == 0) { bf16_t* dst = (bf16_t*)(ws + WS_QB) + (size_t)tok * 384 + hd * 64 + tn * 32 + 16 * h; *(u32x4*)dst = lo; *(u32x4*)(dst + 8) = hi; }
                        else { unsigned char* img = ws + WS_KVB + ((size_t)((b * 6 + hd) * 260 + (kidx >> 6))) * 16384 + (kidx & 63) * 16;
                            const int c0 = 4 * tn + 2 * h; *(u32x4*)(img + c0 * 1024) = lo; *(u32x4*)(img + (c0 + 1) * 1024) = hi; }
                    }
                }
            } else if (cb < 2304) {
                const int g64 = (cb - 1664) >> 6;
                bf16_t* dst = (bf16_t*)(ws + WS_ZC) + (size_t)tok * 640 + (cb - 1664) + 16 * h;
                float ss = half_sum(sumsq16(acc[tm][T0]) + sumsq16(acc[tm][T0 + 1]));
#pragma unroll
                for (int tn = 0; tn < 2; ++tn) { u32x4 lo, hi; pack16(acc[tm][T0 + tn], lo, hi); *(u32x4*)(dst + tn * 32) = lo; *(u32x4*)(dst + tn * 32 + 8) = hi; }
                if (h == 0) ((float*)(ws + WS_SS))[(size_t)tok * 16 + g64] = ss;
            } else if (cb == 2304) {
                const float ss = half_sum(sumsq16(acc[tm][T0]));
                const float rinv = fast_rsq(ss * (1.0f / 32.0f) + EPS);
                const float* gain = p->c_k_norm + layer * 96 + 64 + 16 * h;
                f32x16 v;
#pragma unroll
                for (int i = 0; i < 16; ++i) v[i] = acc[tm][T0][i] * rinv * gain[i];
                if (tok < NLAT) { const int pp = h ? (kidx & 63) : (kidx >> 6); const float* cs = (const float*)(ws + WS_ROPE) + pp * 16;
#pragma unroll
                    for (int j = 0; j < 8; ++j) { const float c = cs[2 * j], s = cs[2 * j + 1], a = v[j], bb = v[8 + j]; v[j] = a * c - bb * s; v[8 + j] = bb * c + a * s; } }
                u32x4 lo, hi; pack16(v, lo, hi); bf16_t* dst = (bf16_t*)(ws + WS_KR) + (size_t)tok * 32 + 16 * h; *(u32x4*)dst = lo; *(u32x4*)(dst + 8) = hi;
            }
        }
    }
};
struct EpiQup {
    const Params* p; int layer;
    template <int TM, int TN> DEV void run(const f32x16 (&acc)[TM][TN], int mw, int cb, int r, int h) const {
        static_assert(TN == 3, "one 96-column head per wave");
        unsigned char* ws = p->ws; const int hd = cb / 96;
        const float* gain = p->c_q_norm + layer * 96;
        const float QS = 0.10206207261596577f * LOG2E;
#pragma unroll
        for (int tm = 0; tm < TM; ++tm) {
            const int tok = mw + tm * 32 + r; int b, kidx; tok_info(tok, b, kidx);
            const float* ssp = (const float*)(ws + WS_SS) + (size_t)tok * 16;
            const float rq = fast_rsq((ssp[0] + ssp[1] + ssp[2] + ssp[3] + ssp[4] + ssp[5]) * (1.0f / 384.0f) + EPS);
            const float s1 = half_sum(sumsq16(acc[tm][0]) + sumsq16(acc[tm][1])) * rq * rq;
            const float s2 = half_sum(sumsq16(acc[tm][2])) * rq * rq;
            const float r1 = fast_rsq(s1 * (1.0f / 64.0f) + EPS) * rq, r2 = fast_rsq(s2 * (1.0f / 32.0f) + EPS) * rq;
            unsigned char* dst = ws + WS_QC + (size_t)tok * 768 + hd * 128 + 16 * h;
#pragma unroll
            for (int tn = 0; tn < 3; ++tn) { f32x16 v; const float rr = (tn < 2 ? r1 : r2);
#pragma unroll
                for (int i = 0; i < 16; ++i) v[i] = acc[tm][tn][i] * rr * gain[tn * 32 + 16 * h + i];
                if (tn == 2 && tok < NLAT) { const int pp = h ? (kidx & 63) : (kidx >> 6); const float* cs = (const float*)(ws + WS_ROPE) + pp * 16;
#pragma unroll
                    for (int j = 0; j < 8; ++j) { const float c = cs[2 * j], s = cs[2 * j + 1], a = v[j], bb = v[8 + j]; v[j] = a * c - bb * s; v[8 + j] = bb * c + a * s; } }
#pragma unroll
                for (int i = 0; i < 16; ++i) v[i] *= QS * 8.0f;
                *(u32x4*)(dst + tn * 32) = pk_fp8x16(v);
                if (tn == 2) *(u32x4*)(dst + 96) = zero_u32x4(); }
        }
    }
};
struct EpiKVup {
    const Params* p; int layer;
    template <int TM, int TN> DEV void run(const f32x16 (&acc)[TM][TN], int mw, int cb, int r, int h) const {
        static_assert(TN == 2, "64 columns per wave");
        unsigned char* ws = p->ws; const int hd = cb >> 7, isv = (cb >> 6) & 1;
        if (!isv) {
            const float* gain = p->c_k_norm + layer * 96 + 16 * h;
            f32x16 gk[2];
#pragma unroll
            for (int tn = 0; tn < 2; ++tn)
#pragma unroll
                for (int i = 0; i < 16; ++i) gk[tn][i] = gain[tn * 32 + i];
            float rkvs[TM]; u32x4 kr0[TM], kr1[TM];
#pragma unroll
            for (int tm = 0; tm < TM; ++tm) { const int tok = mw + tm * 32 + r;
                const float* ssp = (const float*)(ws + WS_SS) + (size_t)tok * 16 + 6;
                rkvs[tm] = (ssp[0] + ssp[1] + ssp[2] + ssp[3]) * (1.0f / 256.0f) + EPS;
                const u32x4* kr = (const u32x4*)((const bf16_t*)(ws + WS_KR) + (size_t)tok * 32 + 16 * h); kr0[tm] = kr[0]; kr1[tm] = kr[1]; }
#pragma unroll
            for (int tm = 0; tm < TM; ++tm) {
                const int tok = mw + tm * 32 + r; int b, kidx; tok_info(tok, b, kidx);
                const float rkv = fast_rsq(rkvs[tm]);
                unsigned char* img = ws + WS_KVC + ((size_t)((b * 6 + hd) * 130 + (kidx >> 7))) * MLA_IMG;
                const int sub = (kidx >> 6) & 1, key = kidx & 63;
                const float s1 = half_sum(sumsq16(acc[tm][0]) + sumsq16(acc[tm][1])) * rkv * rkv;
                const float r1 = fast_rsq(s1 * (1.0f / 64.0f) + EPS) * rkv;
                unsigned char* kim = img + sub * MLA_KSUB + key * 16;
#pragma unroll
                for (int tn = 0; tn < 2; ++tn) { f32x16 v;
#pragma unroll
                    for (int i = 0; i < 16; ++i) v[i] = acc[tm][tn][i] * r1 * gk[tn][i];
                    *(u32x4*)(kim + (2 * tn + h) * 1024) = pk_fp8x16(v); }
                { const u32x4 k0 = kr0[tm], k1 = kr1[tm]; f32x16 v;
#pragma unroll
                  for (int q = 0; q < 4; ++q) { v[2 * q] = bflo(k0[q]); v[2 * q + 1] = bfhi(k0[q]); v[8 + 2 * q] = bflo(k1[q]); v[8 + 2 * q + 1] = bfhi(k1[q]); }
                  *(u32x4*)(kim + (4 + h) * 1024) = pk_fp8x16(v); *(u32x4*)(kim + (6 + h) * 1024) = zero_u32x4(); }
            }
        }
        if (isv) {
            const int lane = r + 32 * h, tokl = mw + lane; int b, kidx; tok_info(mw, b, kidx);
            const float* ssp = (const float*)(ws + WS_SS) + (size_t)tokl * 16 + 6;
            const float rkv = fast_rsq((ssp[0] + ssp[1] + ssp[2] + ssp[3]) * (1.0f / 256.0f) + EPS);
            unsigned char* vim = ws + WS_KVC + ((size_t)((b * 6 + hd) * 130 + (kidx >> 7))) * MLA_IMG + MLA_VOFF + ((kidx >> 6) & 1) * MLA_VSUB + r * 16;
#pragma unroll
            for (int tm = 0; tm < TM; ++tm) { float rk[16];
#pragma unroll
                for (int i = 0; i < 16; ++i) rk[i] = __builtin_bit_cast(float, __builtin_amdgcn_ds_bpermute((32 * tm + crow(i, h)) << 2, __builtin_bit_cast(int, rkv)));
#pragma unroll
                for (int tn = 0; tn < 2; ++tn) { f32x16 v;
#pragma unroll
                    for (int i = 0; i < 16; ++i) v[i] = acc[tm][tn][i] * rk[i];
                    *(u32x4*)(vim + (2 * h + tm) * 1024 + tn * 512) = pk_fp8x16(v); } }
        }
    }
};
struct EpiOut {
    const Params* p; int layer;
    template <int TM, int TN> DEV void run(const f32x16 (&acc)[TM][TN], int mw, int cb, int r, int h) const {
        unsigned char* ws = p->ws; bf16_t* X = (bf16_t*)(ws + WS_X);
        const float* mod = (const float*)(ws + WS_MOD) + (size_t)layer * 3 * 6144;
#pragma unroll
        for (int tm = 0; tm < TM; ++tm) {
            const int tok = mw + tm * 32 + r;
            const float* base = tok < NLAT ? p->x + (size_t)tok * 1024 : p->ctx + (size_t)(tok - NLAT) * 1024;
            const float* g1 = mod + mod_row(tok) * 6144 + 2048;
#pragma unroll
            for (int tn = 0; tn < TN; ++tn) { const int col = cb + tn * 32 + 16 * h;
#pragma unroll
                for (int q = 0; q < 4; ++q) { f32x4 bv; const f32x4 gv = *(const f32x4*)(g1 + col + 4 * q); f32x4 o;
                    if (layer == 0) bv = *(const f32x4*)(base + col + 4 * q);
                    else { const u32x2 b2 = *(const u32x2*)(X + (size_t)tok * 1024 + col + 4 * q); bv = (f32x4){bflo(b2[0]), bfhi(b2[0]), bflo(b2[1]), bfhi(b2[1])}; }
#pragma unroll
                    for (int j = 0; j < 4; ++j) o[j] = bv[j] + gv[j] * acc[tm][tn][4 * q + j];
                    *(u32x2*)(X + (size_t)tok * 1024 + col + 4 * q) = (u32x2){cvtpk(o[0], o[1]), cvtpk(o[2], o[3])}; } }
        }
    }
};
struct EpiLogits {
    const Params* p;
    template <int TM, int TN> DEV void run(const f32x16 (&acc)[TM][TN], int mw, int cb, int r, int h) const {
        float* LG = (float*)(p->ws + WS_LG);
#pragma unroll
        for (int tm = 0; tm < TM; ++tm) { const int tok = mw + tm * 32 + r;
#pragma unroll
            for (int tn = 0; tn < TN; ++tn) { const int col = cb + tn * 32 + 16 * h;
#pragma unroll
                for (int q = 0; q < 4; ++q) *(f32x4*)(LG + (size_t)tok * 128 + col + 4 * q) = (f32x4){acc[tm][tn][4 * q], acc[tm][tn][4 * q + 1], acc[tm][tn][4 * q + 2], acc[tm][tn][4 * q + 3]}; } }
    }
};
constexpr int LGP = 73, LG_OFF = 98304, RT_OFF = LG_OFF + 128 * LGP * 4;
struct EpiLogitsLds {
    LAS float* lg; int m0;
    template <int TM, int TN> DEV void run(const f32x16 (&acc)[TM][TN], int mw, int cb, int r, int h) const {
#pragma unroll
        for (int tm = 0; tm < TM; ++tm) { const int row = mw - m0 + tm * 32 + r;
#pragma unroll
            for (int tn = 0; tn < TN; ++tn) { const int col = cb + tn * 32 + 16 * h;
#pragma unroll
                for (int i = 0; i < 16; ++i) if (col + i < 72) lg[row * LGP + col + i] = acc[tm][tn][i]; } }
    }
};
struct EpiMoe1 {
    bf16_t* HB; int slot0;
    template <int TM, int TN> DEV void run(const f32x16 (&acc)[TM][TN], int mw, int cb, int r, int h) const {
#pragma unroll
        for (int tm = 0; tm < TM; ++tm) { const int row = slot0 + mw + tm * 32 + r;
#pragma unroll
            for (int tn = 0; tn < TN; ++tn) { float o[8];
#pragma unroll
                for (int j = 0; j < 8; ++j) o[j] = silu_f(acc[tm][tn][j]) * acc[tm][tn][8 + j];
                const u32x4 w = {cvtpk(o[0], o[1]), cvtpk(o[2], o[3]), cvtpk(o[4], o[5]), cvtpk(o[6], o[7])};
                *(u32x4*)(HB + (size_t)row * 512 + (cb >> 1) + tn * 16 + 8 * h) = w; } }
    }
};
struct EpiMoe2 {
    bf16_t* YS; int slot0;
    template <int TM, int TN> DEV void run(const f32x16 (&acc)[TM][TN], int mw, int cb, int r, int h) const {
#pragma unroll
        for (int tm = 0; tm < TM; ++tm) { const int row = slot0 + mw + tm * 32 + r;
#pragma unroll
            for (int tn = 0; tn < TN; ++tn) { u32x4 lo, hi; pack16(acc[tm][tn], lo, hi); bf16_t* d = YS + (size_t)row * 1024 + cb + tn * 32 + 16 * h; *(u32x4*)d = lo; *(u32x4*)(d + 8) = hi; } }
    }
};

DEV void xpose_item(const float* __restrict__ s0, const float* __restrict__ s1, int ld, int ncols, const float* __restrict__ kscale,
                    bf16_t* __restrict__ dst, int ld_dst, int k0, int nt, int mode, LAS float* tile, bool fp8 = false) {
    const int tid = otid();
#pragma unroll
    for (int rr = 0; rr < 2; ++rr) { const int idx = tid + 512 * rr, krow = idx >> 4, c4 = (idx & 15) * 4; f32x4 v = {0.f, 0.f, 0.f, 0.f};
        if (mode == 0 || mode == 2) { const int c = nt * 64 + c4; if (c < ncols) v = *(const f32x4*)(s0 + (size_t)(k0 + krow) * ld + c); }
        else { const int hid0 = nt * 32; v = (c4 < 32) ? *(const f32x4*)(s0 + (size_t)(k0 + krow) * ld + hid0 + c4) : *(const f32x4*)(s1 + (size_t)(k0 + krow) * ld + hid0 + c4 - 32); }
        const float sc = kscale ? kscale[k0 + krow] : 1.0f;
        tile[krow * 65 + c4] = v[0] * sc; tile[krow * 65 + c4 + 1] = v[1] * sc; tile[krow * 65 + c4 + 2] = v[2] * sc; tile[krow * 65 + c4 + 3] = v[3] * sc; }
    __syncthreads();
    { const int nl = tid >> 3, kc = tid & 7, blk = nl >> 5, rho = nl & 31; int cl;
      if (mode == 0) cl = 32 * blk + perm32(rho);
      else if (mode >= 2) cl = nl;
      else { const int i = (rho & 3) + 4 * (rho >> 3), hh = (rho >> 2) & 1; cl = (i < 8 ? 0 : 32) + 16 * blk + 8 * hh + (i & 7); }
      float v[8];
#pragma unroll
      for (int j = 0; j < 8; ++j) v[j] = tile[(8 * kc + j) * 65 + cl];
      if (fp8) *(u32x2*)((unsigned char*)dst + (size_t)(nt * 64 + nl) * ld_dst + k0 + 8 * kc) = (u32x2){pk_fp8x4(v[0] * 32.f, v[1] * 32.f, v[2] * 32.f, v[3] * 32.f), pk_fp8x4(v[4] * 32.f, v[5] * 32.f, v[6] * 32.f, v[7] * 32.f)};
      else { const u32x4 w = {cvtpk(v[0], v[1]), cvtpk(v[2], v[3]), cvtpk(v[4], v[5]), cvtpk(v[6], v[7])};
      *(u32x4*)(dst + (size_t)(nt * 64 + nl) * ld_dst + k0 + 8 * kc) = w; } }
    __syncthreads();
}

DEV void phase_prologue(const Params& p, LAS char* lds) {
    unsigned char* ws = ows_(p.ws); const int tid = otid(), bid = blockIdx.x, nb = gridDim.x;
    LAS float* tile = (LAS float*)lds;
    for (int it = bid; it < 2 * 48; it += nb) {
        const int l = it / 48, cc = it % 48;
        LAS float* red = (LAS float*)lds;
        const int cq = tid & 31, kg = tid >> 5, kb = kg * 64;
        const float* w = p.w_ada + ((size_t)l * 1024 + kb) * 6144 + cc * 128 + cq * 4;
        f32x4 a0 = {0.f, 0.f, 0.f, 0.f}, a1 = a0, a2 = a0;
        for (int k0 = 0; k0 < 64; k0 += 8) {
            f32x4 wv[8];
#pragma unroll
            for (int q = 0; q < 8; ++q) wv[q] = *(const f32x4*)(w + (size_t)(k0 + q) * 6144);
#pragma unroll
            for (int q = 0; q < 8; ++q) { const int k = kb + k0 + q; const float s0 = silu_f(p.c[k]), s1 = silu_f(p.c[1024 + k]), s2 = silu_f(p.c_ctx[k]); a0 += wv[q] * s0; a1 += wv[q] * s1; a2 += wv[q] * s2; }
        }
#pragma unroll
        for (int e = 0; e < 4; ++e) { red[(kg * 3 + 0) * 128 + cq * 4 + e] = a0[e]; red[(kg * 3 + 1) * 128 + cq * 4 + e] = a1[e]; red[(kg * 3 + 2) * 128 + cq * 4 + e] = a2[e]; }
        __syncthreads();
        if (tid < 384) { const int rw = tid >> 7, c = tid & 127; float sum = 0.f;
#pragma unroll
            for (int g = 0; g < 16; ++g) sum += red[(g * 3 + rw) * 128 + c];
            ((float*)(ws + WS_MOD))[((size_t)l * 3 + rw) * 6144 + cc * 128 + c] = sum + p.b_ada[l * 6144 + cc * 128 + c]; }
        asm volatile("s_waitcnt vmcnt(0)" ::: "memory");
        __syncthreads();
        if (it < 16 && tid == 0) { __builtin_amdgcn_fence(__ATOMIC_RELEASE, "agent"); asm volatile("s_waitcnt vmcnt(0)" ::: "memory"); (void)xb_add((unsigned*)(ws + WS_CTL) + CW_N1FLAG, 1u); }
    }
    if (bid == nb - 1) {
        for (int i = tid; i < 2048; i += 512) { const int pp = i >> 3, j = i & 7; const float inv = exp2f(-(float)j * 0.125f * 13.287712379549449f); const float ang = (float)pp * inv;
            ((float*)(ws + WS_ROPE))[2 * i] = cosf(ang); ((float*)(ws + WS_ROPE))[2 * i + 1] = sinf(ang); }
        for (int l = 0; l < 2; ++l) {
            float m[7] = {0.f, 0.f, 0.f, 0.f, 0.f, 0.f, 0.f};
            for (int i = tid; i < 6 * 15 * 31; i += 512) m[2] = fmaxf(m[2], fabsf(p.b_rpb[l * 6 * 15 * 31 + i]));
            if (tid < 64) { m[0] = fabsf(p.b_q_norm[l * 64 + tid]); m[1] = fabsf(p.b_k_norm[l * 64 + tid]); m[3] = fabsf(p.c_q_norm[l * 96 + tid]); m[4] = fabsf(p.c_k_norm[l * 96 + tid]); }
            if (tid < 32) { m[5] = fabsf(p.c_q_norm[l * 96 + 64 + tid]); m[6] = fabsf(p.c_k_norm[l * 96 + 64 + tid]); }
            LAS float* red = (LAS float*)lds + 8192;
#pragma unroll
            for (int q = 0; q < 7; ++q) { float v = wave_max(m[q]);
                if ((tid & 63) == 0) red[(tid >> 6) * 8 + q] = v; }
            __syncthreads();
            if (tid == 0) { float r[7];
#pragma unroll
                for (int q = 0; q < 7; ++q) { float v = 0.f;
#pragma unroll
                    for (int wv = 0; wv < 8; ++wv) v = fmaxf(v, red[wv * 8 + q]);
                    r[q] = v; }
                float* sc = (float*)(ws + WS_SCAL) + l * 8;
                sc[0] = ((64.f * r[0] * r[1] * 0.125f + r[2]) * 1.05f + 1.0f) * LOG2E;
                sc[1] = ((64.f * r[3] * r[4] + 32.f * r[5] * r[6]) * 0.10206207261596577f * 1.05f + 1.0f) * LOG2E; }
            __syncthreads();
        }
    }
    for (int it = bid; it < 2 * 128; it += nb) {
        const int l = it >> 7, np = it & 127, col = 32 * (np >> 5) + perm32(np & 31);
        bf16_t* d = (bf16_t*)(ws + WS_WRT) + ((size_t)l * 128 + np) * 3072;
        for (int k = tid; k < 1024; k += 512) { float wv = 0.f;
            if (col < 8) wv = p.moe_w_group[((size_t)l * 1024 + k) * 8 + col]; else if (col < 72) wv = p.moe_w_router[((size_t)l * 1024 + k) * 64 + col - 8];
            d[k] = (bf16_t)(cvtpk_h(wv, 0.f) & 0xffffu); }
    }
    for (int i = bid * 512 + tid; i < 2 * 4 * 128 * 128 / 2; i += nb * 512) { const f32x2 v = *(const f32x2*)(p.a_w_s + 2 * (size_t)i); ((unsigned*)(ws + WS_WSP))[i] = cvtpk(v[0], v[1]); }
    const int NIT = 2 * (608 + 54 + 48 + 512); const bool wgt = nb >= 200; const bool light = wgt && (bid < 96 || bid == nb - 1);
    const int heavy_rank = bid - 96, nheavy = nb - 97;
    for (int q = 0;; ++q) { int it;
        if (!wgt) { it = bid + q * nb; if (it >= NIT) break; }
        else if (q < 5) it = bid + q * nb;
        else { if (light) break; it = 5 * nb + heavy_rank + (q - 5) * nheavy; if (it >= NIT) break; }
        const int l = it / 1222; int j = it % 1222;
        if (j < 608) { xpose_item(p.w_in + (size_t)l * 1024 * INW, nullptr, INW, INW, nullptr, (bf16_t*)(ws + WS_WIN) + (size_t)l * INWP * 1024, 1024, (j % 16) * 64, j / 16, (j / 16) < 36 ? 2 : 0, tile); continue; }
        j -= 608;
        if (j < 54) { xpose_item(p.c_w_q_up + (size_t)l * 384 * 576, nullptr, 576, 576, p.c_q_a_norm + l * 384, (bf16_t*)(ws + WS_WQ) + (size_t)l * 576 * 384, 384, (j % 6) * 64, j / 6, 0, tile); continue; }
        j -= 54;
        if (j < 48) { xpose_item(p.c_w_kv_up + (size_t)l * 256 * 768, nullptr, 768, 768, p.c_kv_a_norm + l * 256, (bf16_t*)(ws + WS_WKV) + (size_t)l * 768 * 256, 256, (j % 4) * 64, j / 4, 0, tile); continue; }
        j -= 48;
        if (j < 256) xpose_item(p.w_out + (size_t)l * 1024 * 1024, nullptr, 1024, 1024, nullptr, (bf16_t*)(ws + WS_WOUT) + (size_t)l * 1024 * 1024, 1024, (j % 16) * 64, j / 16, 2, tile);
        else { j -= 256; xpose_item(p.w_out + (size_t)l * 1024 * 1024, nullptr, 1024, 1024, nullptr, (bf16_t*)(ws + WS_WOUTP) + (size_t)l * 1024 * 1024, 1024, (j % 16) * 64, j / 16, 0, tile); }
    }
}

DEV void norm_store(const Params& p, int tok, const float (&xv)[2][8], const float* __restrict__ gain, const float* __restrict__ sh, const float* __restrict__ scl, bool with_lo, int lane) {
    float ss = 0.f;
#pragma unroll
    for (int j = 0; j < 2; ++j)
#pragma unroll
        for (int i = 0; i < 8; ++i) ss += xv[j][i] * xv[j][i];
    ss = wave_sum(ss);
    const float rinv = fast_rsq(ss * (1.0f / 1024.0f) + EPS);
    bf16_t* H = (bf16_t*)(p.ws + WS_H) + (size_t)tok * HLD;
#pragma unroll
    for (int j = 0; j < 2; ++j) { const int col = 8 * lane + 512 * j; float y[8];
        const f32x4 g0 = *(const f32x4*)(gain + col), g1 = *(const f32x4*)(gain + col + 4), s0 = *(const f32x4*)(scl + col), s1 = *(const f32x4*)(scl + col + 4), h0 = *(const f32x4*)(sh + col), h1 = *(const f32x4*)(sh + col + 4);
#pragma unroll
        for (int i = 0; i < 4; ++i) { y[i] = xv[j][i] * rinv * g0[i] * (1.0f + s0[i]) + h0[i]; y[4 + i] = xv[j][4 + i] * rinv * g1[i] * (1.0f + s1[i]) + h1[i]; }
        if (!with_lo) { const u32x4 w = {cvtpk(y[0], y[1]), cvtpk(y[2], y[3]), cvtpk(y[4], y[5]), cvtpk(y[6], y[7])}; *(u32x4*)(H + col) = w; }
        else { *(u32x2*)((unsigned char*)H + col) = (u32x2){pk_fp8x4(y[0], y[1], y[2], y[3]), pk_fp8x4(y[4], y[5], y[6], y[7])};
            const u32x4 wl = {cvtpk_h(y[0], y[1]), cvtpk_h(y[2], y[3]), cvtpk_h(y[4], y[5]), cvtpk_h(y[6], y[7])};
            *(u32x4*)(H + 1024 + col) = wl; } }
}
struct NormRegs { f32x4 g[2][2], s[2][2], h[2][2]; };
DEV NormRegs norm_regs(const float* __restrict__ gain, const float* __restrict__ sh, const float* __restrict__ scl, int lane) {
    NormRegs r;
#pragma unroll
    for (int j = 0; j < 2; ++j) { const int col = 8 * lane + 512 * j;
        r.g[j][0] = *(const f32x4*)(gain + col); r.g[j][1] = *(const f32x4*)(gain + col + 4); r.s[j][0] = *(const f32x4*)(scl + col); r.s[j][1] = *(const f32x4*)(scl + col + 4);
        r.h[j][0] = *(const f32x4*)(sh + col); r.h[j][1] = *(const f32x4*)(sh + col + 4); }
    return r;
}
DEV void norm_store_ffn(const Params& p, int tok, const float (&xv)[2][8], const NormRegs& nr, int lane) {
    float ss = 0.f;
#pragma unroll
    for (int j = 0; j < 2; ++j)
#pragma unroll
        for (int i = 0; i < 8; ++i) ss += xv[j][i] * xv[j][i];
    ss = wave_sum(ss);
    const float rinv = fast_rsq(ss * (1.0f / 1024.0f) + EPS);
    bf16_t* H = (bf16_t*)(p.ws + WS_H) + (size_t)tok * HLD;
#pragma unroll
    for (int j = 0; j < 2; ++j) { const int col = 8 * lane + 512 * j; float y[8];
#pragma unroll
        for (int i = 0; i < 4; ++i) { y[i] = xv[j][i] * rinv * nr.g[j][0][i] * (1.0f + nr.s[j][0][i]) + nr.h[j][0][i]; y[4 + i] = xv[j][4 + i] * rinv * nr.g[j][1][i] * (1.0f + nr.s[j][1][i]) + nr.h[j][1][i]; }
        *(u32x2*)((unsigned char*)H + col) = (u32x2){pk_fp8x4(y[0], y[1], y[2], y[3]), pk_fp8x4(y[4], y[5], y[6], y[7])};
        const u32x4 wl = {cvtpk_h(y[0], y[1]), cvtpk_h(y[2], y[3]), cvtpk_h(y[4], y[5]), cvtpk_h(y[6], y[7])};
        *(u32x4*)(H + 1024 + col) = wl; }
}
DEV void load_row(const float* __restrict__ src, float (&xv)[2][8], int lane) {
#pragma unroll
    for (int j = 0; j < 2; ++j) { const f32x4 a = *(const f32x4*)(src + 8 * lane + 512 * j), b = *(const f32x4*)(src + 8 * lane + 512 * j + 4);
#pragma unroll
        for (int i = 0; i < 4; ++i) { xv[j][i] = a[i]; xv[j][4 + i] = b[i]; } }
}
DEV void load_row_bf(const bf16_t* __restrict__ src, float (&xv)[2][8], int lane) {
#pragma unroll
    for (int j = 0; j < 2; ++j) { const u32x4 a = *(const u32x4*)(src + 8 * lane + 512 * j);
#pragma unroll
        for (int e = 0; e < 4; ++e) { xv[j][2 * e] = bflo(a[e]); xv[j][2 * e + 1] = bfhi(a[e]); } }
}
DEV void phase_norm(const Params& p, int layer, int which) {
    const int tid = otid(), lane = tid & 63, gw = blockIdx.x * 8 + (tid >> 6), nw = gridDim.x * 8;
    const float* mod = (const float*)(p.ws + WS_MOD) + (size_t)layer * 3 * 6144;
    const int ntok = (which == 1 && layer == 1) ? NLAT : NTOK;
    for (int tok0 = gw * 4; tok0 < ntok; tok0 += nw * 4) {
        float xv[4][2][8];
#pragma unroll
        for (int q = 0; q < 4; ++q) { const int tok = tok0 + q;
            if (which == 0 && layer == 0) load_row(tok < NLAT ? p.x + (size_t)tok * 1024 : p.ctx + (size_t)(tok - NLAT) * 1024, xv[q], lane);
            else load_row_bf((const bf16_t*)(p.ws + WS_X) + (size_t)tok * 1024, xv[q], lane); }
#pragma unroll
        for (int q = 0; q < 4; ++q) { const int tok = tok0 + q; const float* m = mod + mod_row(tok) * 6144;
            if (which == 0) norm_store(p, tok, xv[q], p.norm_mix + layer * 1024, m, m + 1024, false, lane);
            else norm_store(p, tok, xv[q], p.norm_ffn + layer * 1024, m + 3072, m + 4096, true, lane); }
    }
}

DEV void gmlp_unit(const Params& p, int layer, int chunk, LAS char* lds) {
    unsigned char* ws = ows_(p.ws); const int tid = otid(), lane = tid & 63, wid = tid >> 6, r = lane & 31, h = lane >> 5;
    const int tok0 = chunk * 128;
    const bf16_t* ZA = (const bf16_t*)(ws + WS_ZA);
    bf16x8 wfa[8][2];
    { const bf16_t* Wp = (const bf16_t*)(ws + WS_WSP) + ((size_t)(layer * 4 + (wid >> 1))) * 128 * 128;
#pragma unroll
      for (int s = 0; s < 8; ++s)
#pragma unroll
          for (int pb = 0; pb < 2; ++pb) wfa[s][pb] = *(const bf16x8*)(Wp + (size_t)((wid & 1) * 64 + pb * 32 + r) * 128 + 16 * s + 8 * h); }
    { const int t = tid >> 2, hd = tid & 3; const bf16_t* src = ZA + (size_t)(tok0 + t) * 512 + 256 + hd * 64; float v[64]; float ss = 0.f;
#pragma unroll
      for (int c = 0; c < 8; ++c) { const u32x4 w = *(const u32x4*)(src + 8 * c);
#pragma unroll
          for (int q = 0; q < 4; ++q) { v[8 * c + 2 * q] = bflo(w[q]); v[8 * c + 2 * q + 1] = bfhi(w[q]); } }
#pragma unroll
      for (int i = 0; i < 64; ++i) ss += v[i] * v[i];
      ss += lx1(ss); ss += lx2(ss);
      const float rinv = fast_rsq(ss * (1.0f / 256.0f) + EPS);
      const float* gain = p.a_v_norm + layer * 256 + hd * 64;
      LAS char* img = lds + hd * 16384 + t * 64;
#pragma unroll
      for (int dh = 0; dh < 2; ++dh)
#pragma unroll
          for (int hh = 0; hh < 2; ++hh)
#pragma unroll
              for (int g = 0; g < 4; ++g) { const int d = 32 * dh + 16 * hh + 4 * g; float y[4];
#pragma unroll
                  for (int j = 0; j < 4; ++j) y[j] = v[d + j] * rinv * gain[d + j];
                  const u32x2 w = {cvtpk(y[0], y[1]), cvtpk(y[2], y[3])};
                  *(LAS u32x2*)(img + dh * 8192 + (8 * g + 4 * hh) * 2) = w; } }
    __syncthreads();
    const int hd = wid >> 1, ph = wid & 1;
    f32x16 acc[2][2];
#pragma unroll
    for (int a = 0; a < 2; ++a)
#pragma unroll
        for (int b = 0; b < 2; ++b)
#pragma unroll
            for (int i = 0; i < 16; ++i) acc[a][b][i] = 0.f;
    LAS char* vb = lds + hd * 16384 + 32 * ((lane >> 4) & 1) + 8 * (lane & 3) + ((lane & 15) >> 2) * 64;
#pragma unroll
    for (int s = 0; s < 8; ++s) {
        bf16x8 vf[2];
#pragma unroll
        for (int dh = 0; dh < 2; ++dh) { LAS char* a = vb + dh * 8192 + (16 * s + 8 * h) * 64; vf[dh] = cat4(lds_tr(a), lds_tr(a + 256)); }
#pragma unroll
        for (int pb = 0; pb < 2; ++pb)
#pragma unroll
            for (int dh = 0; dh < 2; ++dh) acc[pb][dh] = MFMA(vf[dh], wfa[s][pb], acc[pb][dh]);
    }
    bf16_t* MIX = (bf16_t*)(ws + WS_MIX);
#pragma unroll
    for (int pb = 0; pb < 2; ++pb) { const int pp = ph * 64 + pb * 32 + r, tok = tok0 + pp; const float bias = p.a_b_s[(layer * 4 + hd) * 128 + pp];
#pragma unroll
        for (int dh = 0; dh < 2; ++dh) { const int col = hd * 64 + dh * 32 + 16 * h; const u32x4 u0 = *(const u32x4*)(ZA + (size_t)tok * 512 + col), u1 = *(const u32x4*)(ZA + (size_t)tok * 512 + col + 8); f32x16 o;
#pragma unroll
            for (int q = 0; q < 4; ++q) { o[2 * q] = bflo(u0[q]) * (acc[pb][dh][2 * q] + bias); o[2 * q + 1] = bfhi(u0[q]) * (acc[pb][dh][2 * q + 1] + bias);
                o[8 + 2 * q] = bflo(u1[q]) * (acc[pb][dh][8 + 2 * q] + bias); o[8 + 2 * q + 1] = bfhi(u1[q]) * (acc[pb][dh][8 + 2 * q + 1] + bias); }
            u32x4 lo, hi; pack16(o, lo, hi); *(u32x4*)(MIX + (size_t)tok * 1024 + col) = lo; *(u32x4*)(MIX + (size_t)tok * 1024 + col + 8) = hi; } }
    __syncthreads();
}

template <int ND> DEV void qk_tile(LAS char* kimg, const bf16x8 (&qf)[ND], float cinit, f32x16 (&s)[2], int r, int h) {
#pragma unroll
    for (int kb = 0; kb < 2; ++kb)
#pragma unroll
        for (int i = 0; i < 16; ++i) s[kb][i] = cinit;
    bf16x8 kf[ND][2];
#pragma unroll
    for (int d0 = 0; d0 < ND; ++d0)
#pragma unroll
        for (int kb = 0; kb < 2; ++kb) kf[d0][kb] = lds_b128(kimg + (2 * d0 + h) * 1024 + (32 * kb + r) * 16);
#pragma unroll
    for (int d0 = 0; d0 < ND; ++d0) {
#pragma unroll
        for (int kb = 0; kb < 2; ++kb) s[kb] = MFMA(kf[d0][kb], qf[d0], s[kb]);
    }
}
DEV void pv_tile(LAS char* vimg, const f32x16 (&pr)[2], f32x16 (&o)[2], int lane) {
    const int h = lane >> 5;
    LAS char* vb = vimg + 32 * ((lane >> 4) & 1) + 8 * (lane & 3) + (4 * h + ((lane & 15) >> 2)) * 64;
    bf16x8 vf[4][2];
#pragma unroll
    for (int ks = 0; ks < 4; ++ks)
#pragma unroll
        for (int dh = 0; dh < 2; ++dh) { LAS char* a = vb + dh * 4096 + ks * 1024; vf[ks][dh] = cat4(lds_tr(a), lds_tr(a + 512)); }
#pragma unroll
    for (int ks = 0; ks < 4; ++ks) { const int kb = ks >> 1, s8 = (ks & 1) * 8;
        const u32x4 pw = {cvtpk(pr[kb][s8], pr[kb][s8 + 1]), cvtpk(pr[kb][s8 + 2], pr[kb][s8 + 3]), cvtpk(pr[kb][s8 + 4], pr[kb][s8 + 5]), cvtpk(pr[kb][s8 + 6], pr[kb][s8 + 7])};
        const bf16x8 pf = __builtin_bit_cast(bf16x8, pw);
#pragma unroll
        for (int dh = 0; dh < 2; ++dh) o[dh] = MFMA(vf[ks][dh], pf, o[dh]);
    }
}
DEV void attn_store(bf16_t* dst, const f32x16 (&o)[2], float lsum, int h) {
    const float inv = fast_rcp(half_sum(lsum));
#pragma unroll
    for (int dh = 0; dh < 2; ++dh) { f32x16 v;
#pragma unroll
        for (int i = 0; i < 16; ++i) v[i] = o[dh][i] * inv;
        u32x4 lo, hi; pack16(v, lo, hi); *(u32x4*)(dst + dh * 32 + 16 * h) = lo; *(u32x4*)(dst + dh * 32 + 16 * h + 8) = hi; }
}

DEV void na_unit(const Params& p, int layer, int b, int hd, int rg, bool ctxq, LAS char* lds) {
    unsigned char* ws = ows_(p.ws); const int tid = otid(), lane = tid & 63, wid = tid >> 6, r = lane & 31, h = lane >> 5;
    constexpr int STG = 16384, TB_OFF = 3 * STG;
    LAS float* tb = (LAS float*)(lds + TB_OFF);
    const float cinit = -((const float*)(ws + WS_SCAL))[layer * 8 + 0];
    int qrow = 0, cq = 0, tok, T0 = 0, ntl = 0, my0 = 0, wlo = 0, whi = 0, ks0 = 0;
    if (!ctxq) { const int rp = rg * 4 + 2 * (wid >> 2), cb = wid & 3; qrow = rp + (r >> 4); cq = 16 * cb + (r & 15); tok = b * SEQ + qrow * 64 + cq;
        const int R = rg * 4; T0 = min(max(R - 4, 0), 248); const int T1 = min(max(R + 3 - 4, 0), 248) + 7; ntl = T1 - T0 + 1; my0 = min(max(qrow - 4, 0), 248);
        wlo = min(max(rp - 4, 0), 248); whi = min(max(rp + 1 - 4, 0), 248) + 8; ks0 = min(max(16 * cb - 8, 0), 32);
        for (int i = tid; i < 15 * 128; i += 512) { const int dr = i >> 7, d = (i & 127) - 64; tb[i] = (d >= -15 && d <= 15) ? p.b_rpb[((layer * 6 + hd) * 15 + dr) * 31 + d + 15] * LOG2E : -1e30f; }
    } else tok = NLAT + b * 256 + 32 * wid + r;
    const int nt = ntl + 4;
    bf16x8 qf[4];
#pragma unroll
    for (int d0 = 0; d0 < 4; ++d0) qf[d0] = *(const bf16x8*)((const bf16_t*)(ws + WS_QB) + (size_t)tok * 384 + hd * 64 + 16 * d0 + 8 * h);
    const unsigned char* imgs = ws + WS_KVB + (size_t)((b * 6 + hd) * 260) * 16384;
    const unsigned ldsw = (unsigned)__builtin_amdgcn_readfirstlane((int)(lds_addr(lds) + (unsigned)(wid * 2048)));
#define NA_ISSUE(j_, st_) do { const int ti_ = (j_) < ntl ? T0 + (j_) : 256 + (j_) - ntl; const unsigned char* s_ = imgs + (size_t)ti_ * 16384 + wid * 2048 + lane * 16; const unsigned d_ = ldsw + (unsigned)((st_) * STG); \
    glds16a(s_, d_); glds16a(s_ + 1024, d_ + 1024); } while (0)
    NA_ISSUE(0, 0); NA_ISSUE(1, 1);
    f32x16 o[2];
#pragma unroll
    for (int dh = 0; dh < 2; ++dh)
#pragma unroll
        for (int i = 0; i < 16; ++i) o[dh][i] = 0.f;
    float lsum = 0.f;
    const int c0 = min(max(cq - 8, 0), 48);
    int st = 0, stn = 2;
    for (int j = 0; j < nt; ++j) {
        if (j + 1 < nt) WAITV(2); else WAITV(0);
        SBAR();
        if (j + 2 < nt) NA_ISSUE(j + 2, stn);
        LAS char* img = lds + st * STG;
        const bool local = j < ntl; const int kr = T0 + j;
        if (local) {
            if (kr >= wlo && kr < whi) {
                f32x16 sc;
#pragma unroll
                for (int i = 0; i < 16; ++i) sc[i] = cinit;
                bf16x8 kf[4], vf[2][2]; float bias[16];
#pragma unroll
                for (int d0 = 0; d0 < 4; ++d0) kf[d0] = lds_b128(img + (2 * d0 + h) * 1024 + (ks0 + r) * 16);
                LAS float* trow = tb + (kr - qrow + 7) * 128 + (ks0 + 4 * h - cq + 64);
#pragma unroll
                for (int i = 0; i < 16; ++i) bias[i] = trow[(i & 3) + 8 * (i >> 2)];
                LAS char* vb = img + 8192 + ks0 * 64 + 32 * ((lane >> 4) & 1) + 8 * (lane & 3) + (4 * h + ((lane & 15) >> 2)) * 64;
#pragma unroll
                for (int ks = 0; ks < 2; ++ks)
#pragma unroll
                    for (int dh = 0; dh < 2; ++dh) { LAS char* a = vb + dh * 4096 + ks * 1024; vf[ks][dh] = cat4(lds_tr(a), lds_tr(a + 512)); }
#pragma unroll
                for (int d0 = 0; d0 < 4; ++d0) sc = MFMA(kf[d0], qf[d0], sc);
                const bool rowok = kr >= my0 && kr < my0 + 8;
#pragma unroll
                for (int i = 0; i < 16; ++i) { const int kc0 = (i & 3) + 8 * (i >> 2);
                    const bool inw = rowok && (unsigned)(ks0 + kc0 + 4 * h - c0) < 16u;
                    sc[i] = ex2(inw ? sc[i] + bias[i] : -1.0e30f); }
#pragma unroll
                for (int i = 0; i < 16; ++i) lsum += sc[i];
#pragma unroll
                for (int ks = 0; ks < 2; ++ks) { const int s8 = ks * 8;
                    const u32x4 pw = {cvtpk(sc[s8], sc[s8 + 1]), cvtpk(sc[s8 + 2], sc[s8 + 3]), cvtpk(sc[s8 + 4], sc[s8 + 5]), cvtpk(sc[s8 + 6], sc[s8 + 7])};
                    const bf16x8 pf = __builtin_bit_cast(bf16x8, pw);
#pragma unroll
                    for (int dh = 0; dh < 2; ++dh) o[dh] = MFMA(vf[ks][dh], pf, o[dh]); }
            }
        } else {
            f32x16 s[2]; qk_tile<4>(img, qf, cinit, s, r, h);
#pragma unroll
            for (int kb = 0; kb < 2; ++kb)
#pragma unroll
                for (int i = 0; i < 16; ++i) s[kb][i] = ex2(s[kb][i]);
#pragma unroll
            for (int kb = 0; kb < 2; ++kb)
#pragma unroll
                for (int i = 0; i < 16; ++i) lsum += s[kb][i];
            pv_tile(img + 8192, s, o, lane);
        }
        st = (st == 2) ? 0 : st + 1; stn = (stn == 2) ? 0 : stn + 1;
    }
#undef NA_ISSUE
    attn_store((bf16_t*)(ws + WS_MIX) + (size_t)tok * 1024 + 256 + hd * 64, o, lsum, h);
    SBAR();
    __syncthreads();
}

struct SideJob { int g; int le; int j; f32x4 v0, v1; };
constexpr int SJ_TILE_OFF = 3 * MLA_IMG;
struct SjDesc { const float* s0; const float* s1; unsigned char* dst; int ld, ld_dst, k0, nt, mode; };
DEV SjDesc sj_desc(const Params& p, int layer, int le_, int j) {
    SjDesc d; const int le = layer * 64 + le_;
    if (j < 256) { d.s0 = p.moe_w1 + (size_t)le * 1024 * 512; d.s1 = p.moe_w3 + (size_t)le * 1024 * 512; d.dst = p.ws + WS_W13 + (size_t)le * 1024 * 1024; d.ld = 512; d.ld_dst = 1024; d.k0 = (j & 15) * 64; d.nt = j >> 4; d.mode = 3; }
    else { const int jj = j - 256; d.s0 = p.moe_w2 + (size_t)le * 512 * 1024; d.s1 = d.s0; d.dst = p.ws + WS_W2 + (size_t)le * 1024 * 512; d.ld = 1024; d.ld_dst = 512; d.k0 = (jj & 7) * 64; d.nt = jj >> 3; d.mode = 2; }
    return d;
}
DEV void sj_advance(SideJob& sj) { sj.j += (int)gridDim.x; while (sj.j >= 384) { sj.j -= 384; ++sj.le; } }
DEV void sj_tick(const Params& p, int layer, SideJob& sj, LAS char* lds, int tid) {
    LAS float* tile = (LAS float*)(lds + SJ_TILE_OFF);
    const int ph = sj.g & 3; ++sj.g;
    if (sj.le >= 64 || ph == 3) return;
    const SjDesc d = sj_desc(p, layer, sj.le, sj.j);
    if (ph == 0) {
        const int krow = tid >> 4, c4 = (tid & 15) * 4;
        const float* a0 = (d.mode == 0 || d.mode == 2) ? d.s0 + (size_t)(d.k0 + krow) * d.ld + d.nt * 64 + c4
                                        : ((c4 < 32) ? d.s0 + (size_t)(d.k0 + krow) * 512 + d.nt * 32 + c4 : d.s1 + (size_t)(d.k0 + krow) * 512 + d.nt * 32 + c4 - 32);
        sj.v0 = *(const f32x4*)a0; sj.v1 = *(const f32x4*)(a0 + (size_t)32 * d.ld);
    } else if (ph == 1) {
        const int krow = tid >> 4, c4 = (tid & 15) * 4;
        LAS float* t0 = tile + krow * 65 + c4; LAS float* t1 = t0 + 32 * 65;
        t0[0] = sj.v0[0]; t0[1] = sj.v0[1]; t0[2] = sj.v0[2]; t0[3] = sj.v0[3]; t1[0] = sj.v1[0]; t1[1] = sj.v1[1]; t1[2] = sj.v1[2]; t1[3] = sj.v1[3];
    } else {
        const int nl = tid >> 3, kc = tid & 7, blk = nl >> 5, rho = nl & 31; int cl;
        if (d.mode == 0) cl = 32 * blk + perm32(rho);
        else if (d.mode >= 2) cl = nl;
        else { const int i = (rho & 3) + 4 * (rho >> 3), hh = (rho >> 2) & 1; cl = (i < 8 ? 0 : 32) + 16 * blk + 8 * hh + (i & 7); }
        float v[8];
#pragma unroll
        for (int j = 0; j < 8; ++j) v[j] = tile[(8 * kc + j) * 65 + cl];
        *(u32x2*)(d.dst + (size_t)(d.nt * 64 + nl) * d.ld_dst + d.k0 + 8 * kc) = (u32x2){pk_fp8x4(v[0] * 32.f, v[1] * 32.f, v[2] * 32.f, v[3] * 32.f), pk_fp8x4(v[4] * 32.f, v[5] * 32.f, v[6] * 32.f, v[7] * 32.f)};
        sj_advance(sj);
    }
}

#define MLA_SB() __builtin_amdgcn_sched_barrier(0)
#define MLA_PIN(x) asm volatile("" : "+v"(x))
#define MLA_KF(kp, g) lds_b128((kp) + ((g) >> 1) * 2048 + ((g) & 1) * 512)
#define MLA_VF(vp, g) cat4(lds_tr((vp) + ((g) & 1) * 4096 + ((g) >> 1) * 1024), lds_tr((vp) + ((g) & 1) * 4096 + ((g) >> 1) * 1024 + 512))
#define MFMA8(a, b, c) __builtin_amdgcn_mfma_scale_f32_32x32x64_f8f6f4((a), (b), (c), 0, 0, 0, 0x7f7f7f7f, 0, 0x7c7c7c7c)
DEV v8i mla_kf8(LAS char* kp, int kb, int sx) {
    const u32x4 a = *(LAS u32x4*)(kp + sx * 4096 + kb * 512), b = *(LAS u32x4*)(kp + sx * 4096 + 1024 + kb * 512);
    return (v8i){(int)a[0], (int)a[1], (int)a[2], (int)a[3], (int)b[0], (int)b[1], (int)b[2], (int)b[3]}; }
#define MFMA8PV(a, b, c) __builtin_amdgcn_mfma_scale_f32_32x32x64_f8f6f4((a), (b), (c), 0, 1, 0, 0x7f7f7f7f, 0, 0x7f7f7f7f)
DEV v8i mla_vf8(LAS char* vp, int dh) {
    const u32x4 a = *(LAS u32x4*)(vp + dh * 512), b = *(LAS u32x4*)(vp + dh * 512 + 1024);
    return (v8i){(int)a[0], (int)a[1], (int)a[2], (int)a[3], (int)b[0], (int)b[1], (int)b[2], (int)b[3]}; }
DEV unsigned pk_bf8x4(float a, float b, float c, float d, int old = 0) { int w = __builtin_amdgcn_cvt_pk_bf8_f32(a, b, old, false); w = __builtin_amdgcn_cvt_pk_bf8_f32(c, d, w, true); return (unsigned)w; }
template <int VAR> DEV void mla_step(f32x16& C0, f32x16& C1, f32x16& P0, f32x16& P1, f32x16& o0, f32x16& o1, f32x16& lacc,
                  const v8i (&qf)[2], const f32x16& cini, LAS char* kp, LAS char* vp, v8i& pw) {
    v8i kf[2], vf[2];
    const v8i ones8 = {0x38383838, 0x38383838, 0x38383838, 0x38383838, 0x38383838, 0x38383838, 0x38383838, 0x38383838};
    kf[0] = mla_kf8(kp, 0, 0); kf[1] = mla_kf8(kp, 1, 0);
    MLA_SB();
#pragma unroll
    for (int g = 0; g < 4; ++g) {
        const int kb = g & 1, sx = g >> 1;
        if (kb) C1 = MFMA8(kf[1], qf[sx], sx == 0 ? cini : C1); else C0 = MFMA8(kf[0], qf[sx], sx == 0 ? cini : C0);
        if (g < 2) kf[kb] = mla_kf8(kp, kb, 1);
        if (g >= 2) vf[g - 2] = mla_vf8(vp, g - 2);
#pragma unroll
        for (int j = 0; j < 2; ++j) { const int w = 2 * g + j, e = 4 * w;
            if (VAR == 3) pw[w] = __builtin_bit_cast(int, (e < 16) ? P0[e] : P1[e - 16]);
            else pw[w] = (int)((e < 16) ? pk_bf8x4(P0[e], P0[e + 1], P0[e + 2], P0[e + 3], pw[w]) : pk_bf8x4(P1[e - 16], P1[e - 15], P1[e - 14], P1[e - 13], pw[w])); }
        if (g == 3) MLA_PIN(pw);
        MLA_SB();
    }
#pragma unroll
    for (int g = 0; g < 3; ++g) {
        if (g == 0) o0 = MFMA8PV(vf[0], pw, o0); else if (g == 1) o1 = MFMA8PV(vf[1], pw, o1); else lacc = MFMA8PV(ones8, pw, lacc);
        const int e0 = (g * 32) / 3, e1 = ((g + 1) * 32) / 3;
#pragma unroll
        for (int e = e0; e < e1; ++e) { if (VAR == 2 || VAR == 3) continue; if (e < 16) C0[e] = ex2(C0[e]); else C1[e - 16] = ex2(C1[e - 16]); }
        if (g < 2) MLA_PIN(C0);
        if (g > 0) MLA_PIN(C1);
        MLA_SB();
    }
}
template <int VAR> DEV void mla_unit(const Params& p, int layer, int b, int hd, int tokbase, int t0, int t1, LAS char* lds, SideJob& sj) {
    unsigned char* ws = ows_(p.ws); const int tid = otid(), lane = tid & 63, wid = tid >> 6, r = lane & 31, h = lane >> 5;
    constexpr int STG = MLA_IMG;
    const float cinit = 15.0f - ((const float*)(ws + WS_SCAL))[layer * 8 + 1];
    const int tok = tokbase + 32 * wid + r;
    v8i qf[2];
#pragma unroll
    for (int sx = 0; sx < 2; ++sx) { const u32x4* q8 = (const u32x4*)(ws + WS_QC + (size_t)tok * 768 + hd * 128 + 64 * sx + 32 * h); const u32x4 a = q8[0], bq = q8[1];
        qf[sx] = (v8i){(int)a[0], (int)a[1], (int)a[2], (int)a[3], (int)bq[0], (int)bq[1], (int)bq[2], (int)bq[3]}; }
    const unsigned char* imgs = ws + WS_KVC + (size_t)((b * 6 + hd) * 130) * MLA_IMG;
    const unsigned ldsw = (unsigned)__builtin_amdgcn_readfirstlane((int)(lds_addr(lds) + (unsigned)(wid * (STG / 8))));
#define MLA_ISSUE(t_, st_) do { const unsigned char* s_ = imgs + (size_t)(t_) * MLA_IMG + wid * (STG / 8) + lane * 16; const unsigned d_ = ldsw + (unsigned)((st_) * STG); \
    _Pragma("unroll") for (int i_ = 0; i_ < STG / 8192; ++i_) glds16a(s_ + i_ * 1024, d_ + i_ * 1024); } while (0)
    f32x16 cini, sA0, sA1, sB0, sB1, o0, o1, lacc;
#pragma unroll
    for (int i = 0; i < 16; ++i) { cini[i] = cinit; o0[i] = 0.f; o1[i] = 0.f; lacc[i] = 0.f; }
    const unsigned koffl = (unsigned)(2 * h * 1024 + r * 16);
    const unsigned voffl = (unsigned)MLA_VOFF + (unsigned)(2 * h * 1024 + r * 16);
    const int ns = t1 - t0;
    MLA_ISSUE(t0, 0);
    WAITV(0); SBAR();
    if (ns > 1) MLA_ISSUE(t0 + 1, 1);
    { LAS char* kp = lds + koffl;
      sA0 = MFMA8(mla_kf8(kp, 0, 0), qf[0], cini); sA1 = MFMA8(mla_kf8(kp, 1, 0), qf[0], cini);
      sA0 = MFMA8(mla_kf8(kp, 0, 1), qf[1], sA0); sA1 = MFMA8(mla_kf8(kp, 1, 1), qf[1], sA1);
#pragma unroll
      for (int i = 0; i < 16; ++i) { sA0[i] = ex2(sA0[i]); sA1[i] = ex2(sA1[i]); } }
    int slot = 0;
    v8i pw = {0, 0, 0, 0, 0, 0, 0, 0};
    for (int s = 0; s < ns; ++s) {
        sj_tick(p, layer, sj, lds, tid);
        { LAS char* base = lds + slot * STG; mla_step<VAR>(sB0, sB1, sA0, sA1, o0, o1, lacc, qf, cini, base + MLA_KSUB + koffl, base + voffl, pw); }
        if (s + 1 < ns) {
            const int nslot = (slot == 2) ? 0 : slot + 1;
            WAITV(0); SBAR();
            if (s + 2 < ns) MLA_ISSUE(t0 + s + 2, (nslot == 2) ? 0 : nslot + 1);
            { LAS char* nb = lds + nslot * STG; LAS char* ob = lds + slot * STG; mla_step<VAR>(sA0, sA1, sB0, sB1, o0, o1, lacc, qf, cini, nb + koffl, ob + MLA_VSUB + voffl, pw); }
            slot = nslot;
        }
    }
    {
#pragma unroll
      for (int w = 0; w < 8; ++w) { const int e = 4 * w; pw[w] = (int)((e < 16) ? pk_bf8x4(sB0[e], sB0[e + 1], sB0[e + 2], sB0[e + 3]) : pk_bf8x4(sB1[e - 16], sB1[e - 15], sB1[e - 14], sB1[e - 13])); }
      LAS char* vp = lds + slot * STG + MLA_VSUB + voffl;
      const v8i ones8 = {0x38383838, 0x38383838, 0x38383838, 0x38383838, 0x38383838, 0x38383838, 0x38383838, 0x38383838};
      o0 = MFMA8PV(mla_vf8(vp, 0), pw, o0); o1 = MFMA8PV(mla_vf8(vp, 1), pw, o1); lacc = MFMA8PV(ones8, pw, lacc); }
#undef MLA_ISSUE
    if (VAR == 0 || lacc[0] == -1.2345e-30f) { f32x16 oo[2] = {o0, o1}; attn_store((bf16_t*)(ws + WS_MIX) + (size_t)tok * 1024 + 640 + hd * 64, oo, 0.5f * lacc[0], h); }
    SBAR();
    __syncthreads();
}

DEV void phase_route(const Params& p, int layer, LAS char* lds) {
    unsigned char* ws = ows_(p.ws); const int ntok = layer == 0 ? NTOK : NLAT;
    unsigned* cnt = (unsigned*)(ws + WS_CTL) + CW_CNT + 2048 * layer;
    int* list = (int*)(ws + WS_LIST);
    LAS unsigned* hist = (LAS unsigned*)lds; LAS unsigned* gbase = hist + 64;
    const int tid = otid(), per = (ntok + (int)gridDim.x - 1) / (int)gridDim.x;
    const int tok = blockIdx.x * per + tid; const bool act = tid < per && tok < ntok;
    if (tid < 64) hist[tid] = 0u;
    __syncthreads();
    int ea = 0, eb = 0; float w1 = 0.f, w2 = 0.f; unsigned la = 0, lb = 0;
    if (act) {
        const float* lg = (const float*)(ws + WS_LG) + (size_t)tok * 128;
        float gl[8];
#pragma unroll
        for (int q = 0; q < 2; ++q) { const f32x4 v = *(const f32x4*)(lg + 4 * q); gl[4 * q] = v[0]; gl[4 * q + 1] = v[1]; gl[4 * q + 2] = v[2]; gl[4 * q + 3] = v[3]; }
        int g = 0; float gm = gl[0];
#pragma unroll
        for (int j = 1; j < 8; ++j) if (gl[j] > gm) { gm = gl[j]; g = j; }
        float gs = 0.f;
#pragma unroll
        for (int j = 0; j < 8; ++j) gs += __expf(gl[j] - gm);
        const float gate = 1.0f / gs;
        float el[8]; { const f32x4 a = *(const f32x4*)(lg + 8 + 8 * g), c = *(const f32x4*)(lg + 12 + 8 * g); el[0] = a[0]; el[1] = a[1]; el[2] = a[2]; el[3] = a[3]; el[4] = c[0]; el[5] = c[1]; el[6] = c[2]; el[7] = c[3]; }
        int i1 = 0; float m1 = el[0];
#pragma unroll
        for (int j = 1; j < 8; ++j) if (el[j] > m1) { m1 = el[j]; i1 = j; }
        int i2 = -1; float m2 = -3.0e38f;
#pragma unroll
        for (int j = 0; j < 8; ++j) if (j != i1 && el[j] > m2) { m2 = el[j]; i2 = j; }
        const float e2 = __expf(m2 - m1); w1 = gate / (1.0f + e2); w2 = gate * e2 / (1.0f + e2);
        ea = g * 8 + i1; eb = g * 8 + i2;
        la = __hip_atomic_fetch_add(&hist[ea], 1u, __ATOMIC_RELAXED, __HIP_MEMORY_SCOPE_WORKGROUP);
        lb = __hip_atomic_fetch_add(&hist[eb], 1u, __ATOMIC_RELAXED, __HIP_MEMORY_SCOPE_WORKGROUP);
    }
    __syncthreads();
    if (tid < 64) { const unsigned c = hist[tid]; gbase[tid] = c ? atomicAdd(&cnt[tid * 32], c) : 0u; }
    __syncthreads();
    if (act) {
        const unsigned pa = gbase[ea] + la, pb = gbase[eb] + lb;
        list[(size_t)ea * MOE_CAP + pa] = tok; list[(size_t)eb * MOE_CAP + pb] = tok;
        ((u32x4*)(ws + WS_TIE))[tok] = (u32x4){((unsigned)ea << 16) | pa, ((unsigned)eb << 16) | pb, __float_as_uint(w1), __float_as_uint(w2)};
    }
    __syncthreads();
}
template <int ROWS> DEV void ffn_front_unit(const Params& p, int layer, int m0, LAS char* lds) {
    unsigned char* ws = ows_(p.ws); const int tid = otid(), lane = tid & 63, wid = tid >> 6;
    const float* mod = (const float*)(ws + WS_MOD) + (size_t)layer * 3 * 6144;
    const float* mu = mod + mod_row(m0) * 6144;
    const NormRegs nr = norm_regs(p.norm_ffn + layer * 1024, mu + 3072, mu + 4096, lane);
    for (int r0 = wid * 4; r0 < ROWS; r0 += 32) {
        float xv[4][2][8];
#pragma unroll
        for (int q = 0; q < 4; ++q) load_row_bf((const bf16_t*)(ws + WS_X) + (size_t)(m0 + r0 + q) * 1024, xv[q], lane);
#pragma unroll
        for (int q = 0; q < 4; ++q) norm_store_ffn(p, m0 + r0 + q, xv[q], nr, lane); }
    asm volatile("s_waitcnt vmcnt(0)" ::: "memory");
    __syncthreads();
    if (wid == 0) { __builtin_amdgcn_fence(__ATOMIC_ACQUIRE, "agent"); asm volatile("s_waitcnt vmcnt(0)" ::: "memory"); }
    __syncthreads();
    LAS float* lg = (LAS float*)(lds + LG_OFF);
    { EpiLogitsLds E{lg, m0};
      if (ROWS == 128) gemm_unit<128, 128, 4, 2, 4, EpiLogitsLds, true>((const bf16_t*)(ws + WS_H) + 1024, HLD, nullptr, 0, m0, 1 << 30, (const bf16_t*)(ws + WS_WRT) + (size_t)layer * 128 * 3072, 3072, 0, 16, lds, E);
      else gemm_unit<64, 128, 2, 4, 6, EpiLogitsLds, true>((const bf16_t*)(ws + WS_H) + 1024, HLD, nullptr, 0, m0, 1 << 30, (const bf16_t*)(ws + WS_WRT) + (size_t)layer * 128 * 3072, 3072, 0, 16, lds, E); }
    LAS unsigned* hist = (LAS unsigned*)(lds + RT_OFF); LAS unsigned* gbase = hist + 64;
    if (tid < 64) hist[tid] = 0u;
    __syncthreads();
    unsigned* cnt = (unsigned*)(ws + WS_CTL) + CW_CNT + 2048 * layer;
    int* list = (int*)(ws + WS_LIST);
    const bool act = tid < ROWS; const int tok = m0 + tid;
    int ea = 0, eb = 0; float w1 = 0.f, w2 = 0.f; unsigned la = 0, lb = 0;
    if (act) {
        LAS float* l = lg + tid * LGP;
        int g = 0; float gm = l[0];
#pragma unroll
        for (int j = 1; j < 8; ++j) if (l[j] > gm) { gm = l[j]; g = j; }
        float gs = 0.f;
#pragma unroll
        for (int j = 0; j < 8; ++j) gs += __expf(l[j] - gm);
        const float gate = 1.0f / gs;
        float el[8];
#pragma unroll
        for (int j = 0; j < 8; ++j) el[j] = l[8 + 8 * g + j];
        int i1 = 0; float m1 = el[0];
#pragma unroll
        for (int j = 1; j < 8; ++j) if (el[j] > m1) { m1 = el[j]; i1 = j; }
        int i2 = -1; float m2 = -3.0e38f;
#pragma unroll
        for (int j = 0; j < 8; ++j) if (j != i1 && el[j] > m2) { m2 = el[j]; i2 = j; }
        const float e2 = __expf(m2 - m1); w1 = gate / (1.0f + e2); w2 = gate * e2 / (1.0f + e2);
        ea = g * 8 + i1; eb = g * 8 + i2;
        la = __hip_atomic_fetch_add(&hist[ea], 1u, __ATOMIC_RELAXED, __HIP_MEMORY_SCOPE_WORKGROUP);
        lb = __hip_atomic_fetch_add(&hist[eb], 1u, __ATOMIC_RELAXED, __HIP_MEMORY_SCOPE_WORKGROUP);
    }
    __syncthreads();
    if (tid < 64) { const unsigned c = hist[tid]; gbase[tid] = c ? atomicAdd(&cnt[tid * 32], c) : 0u; }
    __syncthreads();
    if (act) {
        const unsigned pa = gbase[ea] + la, pb = gbase[eb] + lb;
        list[(size_t)ea * MOE_CAP + pa] = tok; list[(size_t)eb * MOE_CAP + pb] = tok;
        ((u32x4*)(ws + WS_TIE))[tok] = (u32x4){((unsigned)ea << 16) | pa, ((unsigned)eb << 16) | pb, __float_as_uint(w1), __float_as_uint(w2)};
    }
    __syncthreads();
}
namespace pg8 {
constexpr int BM = 256, BK = 64, HALF = 128, HTB = HALF * BK * 2;
DEV int lds_byte(int r, int c) { const int st = (r >> 4) * 2 + (c >> 5), rr = r & 15, cc = c & 31, ob = rr * 64 + cc * 2; return st * 1024 + (ob ^ (((ob >> 9) & 1) << 5)); }
DEV void stage_rc(int b, int& R, int& C) { const int st = b / 1024, sb = b % 1024, swz = sb ^ (((sb >> 9) & 1) << 5); R = (st >> 1) * 16 + swz / 64; C = (st & 1) * 32 + (swz % 64) / 2; }
DEV int perm32p(int rho) { const int n = rho >> 4, i = rho & 15; return 8 * (i >> 2) + 4 * n + (i & 3); }
struct Unit { int pm, pn; int arow, brow; int ridx, nvalid; };
struct Gemm { const void* A; const void* Bt; const int* LIST; int lda, ldb, K; };
typedef f32x4 Acc[2][2][4][2];

template <bool GATHER, class Epi, class Sched, bool FP8 = false>
DEV void gemm_phase(LAS char* lds, const Gemm g, const Sched& S, const Epi& E) {
    const int tid = otid(), wid = __builtin_amdgcn_readfirstlane(tid >> 6), lane = tid & 63, wr = wid >> 2, wc = wid & 3, fr = lane & 15, fq = lane >> 4;
    int nt = g.K / 128; asm volatile("" : "+s"(nt));
    int Rr[2], Cc[2];
    unsigned vB[2], vA[2][2];
#pragma unroll
    for (int i = 0; i < 2; ++i) { stage_rc(tid * 16 + i * 8192, Rr[i], Cc[i]); const int Rb = 64 * (Rr[i] >> 5) + (Epi::PERM ? perm32p(Rr[i] & 31) : (Rr[i] & 31));
        vB[i] = (unsigned)(Rb * g.ldb + Cc[i] * 2); vA[0][i] = (unsigned)(Rr[i] * g.lda + Cc[i] * 2); vA[1][i] = (unsigned)((Rr[i] + HALF) * g.lda + Cc[i] * 2); }
#define PG8_GOFF(u_, dst_, hh_) do { if (GATHER) { int r0_, c0_; stage_rc(otid() * 16, r0_, c0_); \
        _Pragma("unroll") for (int i_ = 0; i_ < 2; ++i_) { const int r_ = (hh_) * HALF + i_ * 64 + r0_; \
        const int gr_ = ((const __attribute__((address_space(1))) int*)g.LIST)[(u_).ridx + (r_ < (u_).nvalid ? r_ : 0)];        dst_[hh_][i_] = (unsigned)gr_ * (unsigned)g.lda + (unsigned)(c0_ * 2); } } } while (0)
    const size_t kstep = (size_t)(BK * 2);
    const size_t hstepB = (size_t)32 * g.ldb;
    const unsigned ldsw = (unsigned)wid * 1024u;
    const unsigned ldsb = (unsigned)(size_t)lds + ldsw;
    const size_t dA1 = (size_t)64 * g.lda, dA2 = (size_t)128 * g.lda;
    const size_t dB1 = (size_t)128 * g.ldb;
    const int aoff = lds_byte(wr * 64 + fr, fq * 8), boff = lds_byte(wc * 32 + fr, fq * 8);
#define PG8_SA(b, h) (((b) * 2 + (h)) * HTB)
#define PG8_SB(b, h) ((4 + (b) * 2 + (h)) * HTB)
#define PG8_STAGE2(bufoff, gbase, v0_, v1_) do { if (FP8) { glds16s((gbase), (v0_), ldsb + (unsigned)(bufoff)); glds16s((gbase), (v1_), ldsb + (unsigned)(bufoff) + 8192u); } else { \
        __builtin_amdgcn_global_load_lds((const unsigned*)((const char*)(gbase) + (v0_)), (LAS unsigned*)(lds + (bufoff) + ldsw), 16, 0, 0); \
        __builtin_amdgcn_global_load_lds((const unsigned*)((const char*)(gbase) + (v1_)), (LAS unsigned*)(lds + (bufoff) + ldsw + 8192), 16, 0, 0); } } while (0)
#define PG8_STAGE_B(bufoff, gbase) do { if (FP8) { glds16s((gbase), vB[0], ldsb + (unsigned)(bufoff)); glds16s((gbase) + dB1, vB[0], ldsb + (unsigned)(bufoff) + 8192u); } \
        else PG8_STAGE2(bufoff, gbase, vB[0], vB[1]); } while (0)
#define PG8_STAGE_A(bufoff, gbase, hh, nx) do { if (FP8 && !GATHER) { glds16s((gbase) + (size_t)(hh) * dA2, vA[0][0], ldsb + (unsigned)(bufoff)); glds16s((gbase) + (size_t)(hh) * dA2 + dA1, vA[0][0], ldsb + (unsigned)(bufoff) + 8192u); } \
        else PG8_STAGE2(bufoff, gbase, vA[hh][0], vA[hh][1]); } while (0)
#define PG8_LD8(p_) __builtin_shufflevector(*(const LAS i32x4*)(p_), *(const LAS i32x4*)((p_) + 1024), 0, 1, 2, 3, 4, 5, 6, 7)
#define PG8_LDA(dst, b, h) do { if (FP8) { _Pragma("unroll") for (int m = 0; m < 4; ++m) dst##8[m] = PG8_LD8(lds + PG8_SA(b, h) + aoff + m * 2048); } else { \
        _Pragma("unroll") for (int m = 0; m < 4; ++m) _Pragma("unroll") for (int k = 0; k < 2; ++k) dst[m][k] = *(const LAS bf16x8*)(lds + PG8_SA(b, h) + aoff + m * 2048 + k * 1024); } } while (0)
#define PG8_LDB(dst, b, h) do { if (FP8) { _Pragma("unroll") for (int n = 0; n < 2; ++n) dst##8[n] = PG8_LD8(lds + PG8_SB(b, h) + boff + n * 2048); } else { \
        _Pragma("unroll") for (int n = 0; n < 2; ++n) _Pragma("unroll") for (int k = 0; k < 2; ++k) dst[n][k] = *(const LAS bf16x8*)(lds + PG8_SB(b, h) + boff + n * 2048 + k * 1024); } } while (0)
#define PG8_MMA(ai, bj, At, Bt) do { __builtin_amdgcn_s_setprio(1); _Pragma("unroll") for (int m = 0; m < 4; ++m) _Pragma("unroll") for (int n = 0; n < 2; ++n) _Pragma("unroll") for (int k = 0; k < 2; ++k) \
        acc[ai][bj][m][n] = __builtin_amdgcn_mfma_f32_16x16x32_bf16(Bt[n][k], At[m][k], acc[ai][bj][m][n], 0, 0, 0); __builtin_amdgcn_s_setprio(0); } while (0)
#define PG8_MMA8(ai, bj, At, Bt) do { __builtin_amdgcn_s_setprio(1); _Pragma("unroll") for (int m = 0; m < 4; ++m) _Pragma("unroll") for (int n = 0; n < 2; ++n) \
        acc[ai][bj][m][n] = __builtin_amdgcn_mfma_scale_f32_16x16x128_f8f6f4(Bt##8[n], At##8[m], acc[ai][bj][m][n], 0, 0, 0, 0x7a7a7a7a, 0, 0x7f7f7f7f); __builtin_amdgcn_s_setprio(0); } while (0)
#define PG8_MM(ai, bj, At, Bt) do { if (FP8) PG8_MMA8(ai, bj, At, Bt); else PG8_MMA(ai, bj, At, Bt); } while (0)
#define PG8_WAIT_V(n) asm volatile("s_waitcnt vmcnt(" #n ")" ::: "memory")
#define PG8_WAIT_L(n) asm volatile("s_waitcnt lgkmcnt(" #n ")" ::: "memory")
#define PG8_BAR __builtin_amdgcn_s_barrier()
#define PG8_SCHED __builtin_amdgcn_sched_barrier(0)
    Unit cur, nxt; int ui = 0;
    if (!S.next(0, cur)) return;
    f32x4 acc[2][2][4][2];
#pragma unroll
    for (int a = 0; a < 2; ++a)
#pragma unroll
        for (int b = 0; b < 2; ++b)
#pragma unroll
            for (int m = 0; m < 4; ++m)
#pragma unroll
                for (int n = 0; n < 2; ++n) acc[a][b][m][n] = (f32x4){0.f, 0.f, 0.f, 0.f};
    bf16x8 At[4][2], B0[2][2], B1[2][2]; v8i At8[4], B08[2], B18[2];
    PG8_GOFF(cur, vA, 0); PG8_GOFF(cur, vA, 1);
    const char* cA = (const char*)g.A + (GATHER ? (size_t)0 : (size_t)cur.arow * g.lda); const char* cB = (const char*)g.Bt + (size_t)cur.brow * g.ldb;
    PG8_STAGE_B(PG8_SB(0, 0), cB); PG8_STAGE_B(PG8_SB(0, 1), cB + hstepB); PG8_STAGE_A(PG8_SA(0, 0), cA, 0, false); PG8_STAGE_A(PG8_SA(0, 1), cA, 1, false);
    if (wr == 1) PG8_BAR;
    PG8_WAIT_V(2); PG8_BAR;
    PG8_STAGE_B(PG8_SB(1, 0), cB + kstep); PG8_STAGE_A(PG8_SA(1, 0), cA + kstep, 0, false); PG8_STAGE_B(PG8_SB(1, 1), cB + hstepB + kstep);
    PG8_WAIT_V(6); PG8_BAR;
    for (;;) {
        const bool has_next = S.next(ui + 1, nxt);
        const char* nA = has_next ? (const char*)g.A + (GATHER ? (size_t)0 : (size_t)nxt.arow * g.lda) : cA; const char* nB = has_next ? (const char*)g.Bt + (size_t)nxt.brow * g.ldb : cB;
        for (int t = 0; t < nt; t += 2) {
            const bool last = (t == nt - 2), lastn = last && has_next;
            const char* a1 = cA + (size_t)(t + 1) * kstep;
            const char* a2 = last ? nA : cA + (size_t)(t + 2) * kstep; const char* b2 = last ? nB : cB + (size_t)(t + 2) * kstep;
            const char* a3 = a2 + kstep; const char* b3 = b2 + kstep;
            if (GATHER && lastn) PG8_GOFF(nxt, vA, 0);
            PG8_LDB(B0, 0, 0); PG8_LDB(B1, 0, 1); PG8_SCHED; PG8_LDA(At, 0, 0); PG8_STAGE_A(PG8_SA(1, 1), a1, 1, false);
            if (GATHER && lastn) PG8_GOFF(nxt, vA, 1);
            PG8_WAIT_V(8); PG8_WAIT_L(0); PG8_BAR; PG8_MM(0, 0, At, B0); PG8_MM(0, 1, At, B1); PG8_BAR; PG8_SCHED;
            PG8_LDA(At, 0, 1); PG8_STAGE_B(PG8_SB(0, 0), b2); PG8_STAGE_B(PG8_SB(0, 1), b2 + hstepB); PG8_STAGE_A(PG8_SA(0, 0), a2, 0, lastn);
            PG8_WAIT_V(8); PG8_WAIT_L(0); PG8_BAR; PG8_MM(1, 0, At, B0); PG8_MM(1, 1, At, B1); PG8_BAR; PG8_SCHED;
            PG8_LDB(B0, 1, 0); PG8_LDB(B1, 1, 1); PG8_SCHED; PG8_LDA(At, 1, 0); PG8_STAGE_A(PG8_SA(0, 1), a2, 1, lastn);
            PG8_WAIT_V(8); PG8_WAIT_L(0); PG8_BAR; PG8_MM(0, 0, At, B0); PG8_MM(0, 1, At, B1); PG8_BAR; PG8_SCHED;
            PG8_LDA(At, 1, 1); PG8_STAGE_B(PG8_SB(1, 0), b3); PG8_STAGE_B(PG8_SB(1, 1), b3 + hstepB); PG8_STAGE_A(PG8_SA(1, 0), a3, 0, lastn);
            PG8_WAIT_V(8); PG8_WAIT_L(0); PG8_BAR; PG8_MM(1, 0, At, B0); PG8_MM(1, 1, At, B1); PG8_BAR; PG8_SCHED;
        }
        if (wr == 0) PG8_BAR;
        { const int l2 = otid(); E(acc, cur, wr, wc, l2 & 15, (l2 >> 4) & 3); }
        if (!has_next) break;
#pragma unroll
        for (int a = 0; a < 2; ++a)
#pragma unroll
            for (int b = 0; b < 2; ++b)
#pragma unroll
                for (int m = 0; m < 4; ++m)
#pragma unroll
                    for (int n = 0; n < 2; ++n) acc[a][b][m][n] = (f32x4){0.f, 0.f, 0.f, 0.f};
        cur = nxt; cA = nA; cB = nB; ++ui;
        if (wr == 1) PG8_BAR;
    }
    PG8_WAIT_V(0);
    PG8_BAR;
#undef PG8_GOFF
#undef PG8_SA
#undef PG8_SB
#undef PG8_STAGE2
#undef PG8_STAGE_A
#undef PG8_STAGE_B
#undef PG8_LDA
#undef PG8_LD8
#undef PG8_LDB
#undef PG8_MMA
#undef PG8_MMA8
#undef PG8_MM
#undef PG8_WAIT_V
#undef PG8_WAIT_L
#undef PG8_BAR
#undef PG8_SCHED
}
}


struct EpiInP { static constexpr bool PERM = true; const Params* p; int layer;
    DEV void operator()(const pg8::Acc& acc, const pg8::Unit& u, int wr, int wc, int fr, int fq) const {
        unsigned char* ws = p->ws; const int cb = u.pn * 256 + wc * 64;
        f32x4 gq[2][2] = {};
        if (cb >= 512 && cb < 1280) { const float* gain = (cb < 896 ? p->b_q_norm : p->b_k_norm) + layer * 64;
#pragma unroll
            for (int bj = 0; bj < 2; ++bj) { gq[bj][0] = *(const f32x4*)(gain + 32 * bj + 8 * fq); gq[bj][1] = *(const f32x4*)(gain + 32 * bj + 8 * fq + 4); } }
#pragma unroll
        for (int ai = 0; ai < 2; ++ai)
#pragma unroll
        for (int m = 0; m < 4; ++m) {
            const int tok = u.pm * 256 + ai * 128 + wr * 64 + m * 16 + fr; int b, kidx; tok_info(tok, b, kidx);
            float x[2][8];
#pragma unroll
            for (int bj = 0; bj < 2; ++bj)
#pragma unroll
                for (int n = 0; n < 2; ++n)
#pragma unroll
                    for (int j = 0; j < 4; ++j) x[bj][4 * n + j] = acc[ai][bj][m][n][j];
            if (cb < 512) {
                bf16_t* dst = (bf16_t*)(ws + WS_ZA) + (size_t)tok * 512 + cb + 8 * fq;
#pragma unroll
                for (int bj = 0; bj < 2; ++bj) { float y[8];
#pragma unroll
                    for (int e = 0; e < 8; ++e) y[e] = gelu_tanh(x[bj][e]);
                    *(u32x4*)(dst + 32 * bj) = (u32x4){cvtpk(y[0], y[1]), cvtpk(y[2], y[3]), cvtpk(y[4], y[5]), cvtpk(y[6], y[7])}; }
            } else if (cb < 1664) {
                const int sect = (cb - 512) / 384, hd = ((cb - 512) % 384) >> 6;
                if (sect == 2) {
                    unsigned char* img = ws + WS_KVB + ((size_t)((b * 6 + hd) * 260 + (kidx >> 6))) * 16384 + 8192 + (kidx & 63) * 64;
#pragma unroll
                    for (int bj = 0; bj < 2; ++bj)
#pragma unroll
                        for (int n = 0; n < 2; ++n) { const u32x2 w = {cvtpk(x[bj][4 * n], x[bj][4 * n + 1]), cvtpk(x[bj][4 * n + 2], x[bj][4 * n + 3])};
                            *(u32x2*)(img + bj * 4096 + (16 * (fq & 1) + 8 * n + 4 * (fq >> 1)) * 2) = w; }
                } else {
                    float ss = 0.f;
#pragma unroll
                    for (int bj = 0; bj < 2; ++bj)
#pragma unroll
                        for (int e = 0; e < 8; ++e) ss += x[bj][e] * x[bj][e];
                    ss += lx16(ss); ss = half_sum(ss);
                    const float rinv = fast_rsq(ss * (1.0f / 64.0f) + EPS);
                    const float sc = rinv * (sect == 0 ? 0.125f * LOG2E : 1.0f);
#pragma unroll
                    for (int bj = 0; bj < 2; ++bj) { const f32x4 g0 = gq[bj][0], g1 = gq[bj][1]; float y[8];
#pragma unroll
                        for (int e = 0; e < 4; ++e) { y[e] = x[bj][e] * sc * g0[e]; y[4 + e] = x[bj][4 + e] * sc * g1[e]; }
                        const u32x4 w = {cvtpk(y[0], y[1]), cvtpk(y[2], y[3]), cvtpk(y[4], y[5]), cvtpk(y[6], y[7])};
                        if (sect == 0) *(u32x4*)((bf16_t*)(ws + WS_QB) + (size_t)tok * 384 + hd * 64 + 32 * bj + 8 * fq) = w;
                        else *(u32x4*)(ws + WS_KVB + ((size_t)((b * 6 + hd) * 260 + (kidx >> 6))) * 16384 + (4 * bj + fq) * 1024 + (kidx & 63) * 16) = w; }
                }
            } else {
                bf16_t* dst = (bf16_t*)(ws + WS_ZC) + (size_t)tok * 640 + (cb - 1664) + 8 * fq; float ss = 0.f;
#pragma unroll
                for (int bj = 0; bj < 2; ++bj) {
#pragma unroll
                    for (int e = 0; e < 8; ++e) ss += x[bj][e] * x[bj][e];
                    *(u32x4*)(dst + 32 * bj) = (u32x4){cvtpk(x[bj][0], x[bj][1]), cvtpk(x[bj][2], x[bj][3]), cvtpk(x[bj][4], x[bj][5]), cvtpk(x[bj][6], x[bj][7])}; }
                ss += lx16(ss); ss = half_sum(ss);
                if (fq == 0) ((float*)(ws + WS_SS))[(size_t)tok * 16 + ((cb - 1664) >> 6)] = ss;
            }
        }
    }
};
struct EpiOutP { static constexpr bool PERM = true; const Params* p; int layer;
    DEV void operator()(const pg8::Acc& acc, const pg8::Unit& u, int wr, int wc, int fr, int fq) const {
        unsigned char* ws = p->ws; bf16_t* X = (bf16_t*)(ws + WS_X);
        const int cb = u.pn * 256 + wc * 64 + 8 * fq;
        const float* g1 = (const float*)(ws + WS_MOD) + (size_t)layer * 3 * 6144 + mod_row(u.pm * 256) * 6144 + 2048 + cb;
        f32x4 gv[2][2];
#pragma unroll
        for (int bj = 0; bj < 2; ++bj)
#pragma unroll
            for (int n = 0; n < 2; ++n) gv[bj][n] = *(const f32x4*)(g1 + 32 * bj + 4 * n);
#pragma unroll
        for (int ai = 0; ai < 2; ++ai) {
            if (layer == 0) {
#pragma unroll
                for (int mh = 0; mh < 2; ++mh) {
                    f32x4 raw[2][2][2];
#pragma unroll
                    for (int mm = 0; mm < 2; ++mm) { const int m = mh * 2 + mm; const int tok = u.pm * 256 + ai * 128 + wr * 64 + m * 16 + fr; const float* base = p->x + (size_t)tok * 1024 + cb;
#pragma unroll
                        for (int bj = 0; bj < 2; ++bj) { raw[mm][bj][0] = *(const f32x4*)(base + 32 * bj); raw[mm][bj][1] = *(const f32x4*)(base + 32 * bj + 4); } }
#pragma unroll
                    for (int mm = 0; mm < 2; ++mm) { const int m = mh * 2 + mm; const int tok = u.pm * 256 + ai * 128 + wr * 64 + m * 16 + fr; bf16_t* dst = X + (size_t)tok * 1024 + cb;
#pragma unroll
                        for (int bj = 0; bj < 2; ++bj) { float o[8];
#pragma unroll
                            for (int n = 0; n < 2; ++n)
#pragma unroll
                                for (int j = 0; j < 4; ++j) o[4 * n + j] = raw[mm][bj][n][j] + gv[bj][n][j] * acc[ai][bj][m][n][j];
                            *(u32x4*)(dst + 32 * bj) = (u32x4){cvtpk(o[0], o[1]), cvtpk(o[2], o[3]), cvtpk(o[4], o[5]), cvtpk(o[6], o[7])}; } }
                }
            } else {
                u32x4 raw[4][2];
#pragma unroll
                for (int m = 0; m < 4; ++m) { const int tok = u.pm * 256 + ai * 128 + wr * 64 + m * 16 + fr; const bf16_t* src = X + (size_t)tok * 1024 + cb;
#pragma unroll
                    for (int bj = 0; bj < 2; ++bj) raw[m][bj] = *(const u32x4*)(src + 32 * bj); }
#pragma unroll
                for (int m = 0; m < 4; ++m) { const int tok = u.pm * 256 + ai * 128 + wr * 64 + m * 16 + fr; bf16_t* dst = X + (size_t)tok * 1024 + cb;
#pragma unroll
                    for (int bj = 0; bj < 2; ++bj) { float o[8];
#pragma unroll
                        for (int n = 0; n < 2; ++n)
#pragma unroll
                            for (int j = 0; j < 4; ++j) { const int e = 4 * n + j; const float bvv = (e & 1) ? bfhi(raw[m][bj][e >> 1]) : bflo(raw[m][bj][e >> 1]); o[e] = bvv + gv[bj][n][j] * acc[ai][bj][m][n][j]; }
                        *(u32x4*)(dst + 32 * bj) = (u32x4){cvtpk(o[0], o[1]), cvtpk(o[2], o[3]), cvtpk(o[4], o[5]), cvtpk(o[6], o[7])}; } }
            }
        }
    }
};
struct EpiMoe1P { static constexpr bool PERM = true; unsigned char* HB;
    DEV void operator()(const pg8::Acc& acc, const pg8::Unit& u, int wr, int wc, int fr, int fq) const {
#pragma unroll
        for (int ai = 0; ai < 2; ++ai)
#pragma unroll
        for (int m = 0; m < 4; ++m) { const int row = u.pm * 256 + ai * 128 + wr * 64 + m * 16 + fr; float o[8];
#pragma unroll
            for (int n = 0; n < 2; ++n)
#pragma unroll
                for (int j = 0; j < 4; ++j) o[4 * n + j] = silu_f(acc[ai][0][m][n][j]) * acc[ai][1][m][n][j];
            *(u32x2*)(HB + (size_t)row * 512 + 32 * (4 * u.pn + wc) + 8 * fq) = (u32x2){pk_fp8x4(o[0], o[1], o[2], o[3]), pk_fp8x4(o[4], o[5], o[6], o[7])}; }
    }
};
struct EpiMoe2P { static constexpr bool PERM = true; bf16_t* YS;
    DEV void operator()(const pg8::Acc& acc, const pg8::Unit& u, int wr, int wc, int fr, int fq) const {
#pragma unroll
        for (int ai = 0; ai < 2; ++ai)
#pragma unroll
        for (int m = 0; m < 4; ++m) { const int row = u.pm * 256 + ai * 128 + wr * 64 + m * 16 + fr;
#pragma unroll
            for (int bj = 0; bj < 2; ++bj)
                *(u32x4*)(YS + (size_t)row * 1024 + u.pn * 256 + wc * 64 + 32 * bj + 8 * fq) = (u32x4){cvtpk(acc[ai][bj][m][0][0], acc[ai][bj][m][0][1]), cvtpk(acc[ai][bj][m][0][2], acc[ai][bj][m][0][3]),
                                                                                                       cvtpk(acc[ai][bj][m][1][0], acc[ai][bj][m][1][1]), cvtpk(acc[ai][bj][m][1][2], acc[ai][bj][m][1][3])}; }
    }
};
constexpr int NARROW_PER = 2;
DEV bool xorder_in(int i, int& L, int vb) {
    const int G = gridDim.x;
    if (G & 7) return xorder(1170, i, L, vb);
    const int per = G >> 3, pe = per - NARROW_PER, chunk = (1170 + 7) >> 3, pos = vb % per;
    if (pos >= pe) return false;
    const int j = pos + pe * i;
    if (j >= chunk) return false;
    L = (vb / per) * chunk + j; return L < 1170;
}
struct SchedIn { int layer, vb;
    DEV bool next(int i, pg8::Unit& u) const { int L; if (!xorder_in(i, L, vb)) return false; int mt, nt; tile_of(L, 130, 9, mt, nt);
        u.pm = mt; u.pn = nt; u.arow = mt * 256; u.brow = layer * INWP + nt * 256; u.ridx = 0; u.nvalid = 0; return true; } };
struct SchedOut { int layer, vb;
    DEV bool next(int i, pg8::Unit& u) const { int L; if (!xorder(512, i, L, vb)) return false; int mt, nt; tile_of(L, 128, 4, mt, nt);
        u.pm = mt; u.pn = nt; u.arow = mt * 256; u.brow = layer * 1024 + nt * 256; u.ridx = 0; u.nvalid = 0; return true; } };
template <int WHICH> struct SchedMoe { int layer, vb, nitems; LAS int* bs; LAS int* cn;
    DEV bool next(int i, pg8::Unit& u) const { int it; if (!xorder(nitems, i, it, vb)) return false;
        const int rbi = it >> 2, nt = it & 3; const int ex = (bs - 768)[rbi];
        const int rb = rbi - bs[ex];
        u.pm = rbi; u.pn = nt; u.arow = rbi * MOE_RB; u.brow = (layer * 64 + ex) * 1024 + nt * 256;
        if (WHICH == 0) { u.ridx = ex * MOE_CAP + rb * MOE_RB; u.nvalid = cn[ex] - rb * MOE_RB; } else { u.ridx = 0; u.nvalid = 0; }
        return true; } };

DEV void moe_tables(const Params& p, int layer, LAS int* bs, LAS int* cn) {
    const unsigned* cnt = (const unsigned*)(p.ws + WS_CTL) + CW_CNT + 2048 * layer;
    if (threadIdx.x == 0) { int a = 0; for (int e = 0; e < 64; ++e) { const int c = (int)cnt[e * 32]; cn[e] = c; bs[e] = a; a += (c + MOE_RB - 1) / MOE_RB; } bs[64] = a; }
    __syncthreads();
    { LAS int* rb2e = bs - 768;
      const int t = otid(); if (t < bs[64]) { int ex = 0;
#pragma unroll
          for (int st = 32; st > 0; st >>= 1) if (bs[ex + st] <= t) ex += st;
          rb2e[t] = ex; } }
    __syncthreads();
}
DEV void phase_moe_gemm(const Params& p, int layer, int which, LAS char* lds, int vb, bool have_tables = false) {
    unsigned char* ws = ows_(p.ws);
    LAS int* bs = (LAS int*)(lds + LDS_MAIN - 1024); LAS int* cn = bs + 80;
    if (!have_tables) moe_tables(p, layer, bs, cn);
    const int nrb = bs[64], nitems = nrb * 4;
    if (which == 0) { pg8::Gemm g{ws + WS_H, ws + WS_W13, (const int*)(ws + WS_LIST), HLD * 2, 1024, 1024}; SchedMoe<0> S{layer, vb, nitems, bs, cn}; EpiMoe1P E{ws + WS_HB};
        pg8::gemm_phase<true, EpiMoe1P, SchedMoe<0>, true>(lds, g, S, E); }
    else { pg8::Gemm g{ws + WS_HB, ws + WS_W2, nullptr, 512, 512, 512}; SchedMoe<1> S{layer, vb, nitems, bs, cn}; EpiMoe2P E{(bf16_t*)(ws + WS_YS)};
        pg8::gemm_phase<false, EpiMoe2P, SchedMoe<1>, true>(lds, g, S, E); }
    __syncthreads();
}
DEV void phase_combine(const Params& p, int layer, LAS char* lds, bool have_tables = false) {
    unsigned char* ws = ows_(p.ws);
    LAS int* bs = (LAS int*)(lds + LDS_MAIN - 1024); LAS int* cn = bs + 80;
    if (!have_tables) moe_tables(p, layer, bs, cn);
    const int tid = otid(), lane = tid & 63, gw = blockIdx.x * 8 + (tid >> 6), nw = gridDim.x * 8;
    const int ntok = layer == 0 ? NTOK : NLAT;
    const float* mod = (const float*)(ws + WS_MOD) + (size_t)layer * 3 * 6144;
    const float* modn = (const float*)(ws + WS_MOD) + (size_t)1 * 3 * 6144;
    const bf16_t* YS = (const bf16_t*)(ws + WS_YS);
    struct CRow { u32x4 xr[2], ya[2], yb[2]; float w1, w2; };
    const u32x4* TIE = (const u32x4*)(ws + WS_TIE); const bf16_t* Xr = (const bf16_t*)(ws + WS_X);
    const int step = nw * 2, t0 = gw * 2;
    auto issue_rows = [&](int tok, const u32x4& ti, CRow& R) {
        const int sa = bs[ti[0] >> 16] * MOE_RB + (int)(ti[0] & 0xffffu), sb = bs[ti[1] >> 16] * MOE_RB + (int)(ti[1] & 0xffffu);
        R.w1 = __uint_as_float(ti[2]); R.w2 = __uint_as_float(ti[3]);
#pragma unroll
        for (int j = 0; j < 2; ++j) { const int col = 8 * lane + 512 * j; R.xr[j] = *(const u32x4*)(Xr + (size_t)tok * 1024 + col);
            R.ya[j] = *(const u32x4*)(YS + (size_t)sa * 1024 + col); R.yb[j] = *(const u32x4*)(YS + (size_t)sb * 1024 + col); } };
    CRow cur[2], nxt[2]; u32x4 tin[2] = {{0u, 0u, 0u, 0u}, {0u, 0u, 0u, 0u}};
    if (t0 < ntok) { const u32x4 a0 = TIE[t0], a1 = TIE[t0 + 1]; issue_rows(t0, a0, cur[0]); issue_rows(t0 + 1, a1, cur[1]);
        if (t0 + step < ntok) { tin[0] = TIE[t0 + step]; tin[1] = TIE[t0 + step + 1]; } }
    for (int tok0 = t0; tok0 < ntok; tok0 += step) {
        const int tn = tok0 + step, tnn = tn + step;
        u32x4 tif[2] = {tin[0], tin[1]};
        if (tnn < ntok) { tif[0] = TIE[tnn]; tif[1] = TIE[tnn + 1]; }
        if (tn < ntok) { issue_rows(tn, tin[0], nxt[0]); issue_rows(tn + 1, tin[1], nxt[1]); }
#pragma unroll
        for (int q = 0; q < 2; ++q) { const int tok = tok0 + q;
            float xv[2][8];
#pragma unroll
            for (int j = 0; j < 2; ++j)
#pragma unroll
                for (int e = 0; e < 4; ++e) { xv[j][2 * e] = bflo(cur[q].xr[j][e]); xv[j][2 * e + 1] = bfhi(cur[q].xr[j][e]); }
            bf16_t* X = (bf16_t*)(ws + WS_X) + (size_t)tok * 1024;
            const float* g2 = mod + mod_row(tok) * 6144 + 5120;
            const float w1 = cur[q].w1, w2 = cur[q].w2;
#pragma unroll
            for (int j = 0; j < 2; ++j) { const int col = 8 * lane + 512 * j;
                const f32x4 ga = *(const f32x4*)(g2 + col), gb = *(const f32x4*)(g2 + col + 4);
#pragma unroll
                for (int e = 0; e < 4; ++e) { const float gg0 = e < 2 ? ga[2 * e] : gb[2 * e - 4], gg1 = e < 2 ? ga[2 * e + 1] : gb[2 * e - 3];
                    xv[j][2 * e] += gg0 * (w1 * bflo(cur[q].ya[j][e]) + w2 * bflo(cur[q].yb[j][e])); xv[j][2 * e + 1] += gg1 * (w1 * bfhi(cur[q].ya[j][e]) + w2 * bfhi(cur[q].yb[j][e])); }
                if (layer == 0) *(u32x4*)(X + col) = (u32x4){cvtpk(xv[j][0], xv[j][1]), cvtpk(xv[j][2], xv[j][3]), cvtpk(xv[j][4], xv[j][5]), cvtpk(xv[j][6], xv[j][7])};
                else { float* dst = p.out + (size_t)tok * 1024 + col;
                    *(f32x4*)dst = (f32x4){xv[j][0], xv[j][1], xv[j][2], xv[j][3]}; *(f32x4*)(dst + 4) = (f32x4){xv[j][4], xv[j][5], xv[j][6], xv[j][7]}; } }
            if (layer == 0) { const float* m = modn + mod_row(tok) * 6144; norm_store(p, tok, xv, p.norm_mix + 1024, m, m + 1024, false, lane); } }
        cur[0] = nxt[0]; cur[1] = nxt[1]; tin[0] = tif[0]; tin[1] = tif[1];
    }
}

typedef const __attribute__((address_space(4))) Params* KParamsPtr;
DEV Params load_params() {
#if defined(__HIP_DEVICE_COMPILE__)
    KParamsPtr k = (KParamsPtr)__builtin_amdgcn_kernarg_segment_ptr(); asm volatile("" : "+s"(k));
    return *k;
#else
    return Params{};
#endif
}

constexpr int NPHASE = 1 + 2 * 11;
__global__ void __launch_bounds__(NTHREADS, 2) fwd(const Params p) {
    extern __shared__ __attribute__((aligned(16))) char lds_raw[];
    LAS char* lds = (LAS char*)lds_raw;
    unsigned char* ws0 = p.ws; const int bid = blockIdx.x, nb = gridDim.x;
    volatile LAS unsigned* xbw = (volatile LAS unsigned*)(lds + LDS_MAIN);
    if (threadIdx.x < 4) xbw[threadIdx.x] = 0u;
    __syncthreads();
    XcdBarrier bar; bar.bar = (unsigned*)(ws0 + WS_CTL); bar.x = 0; bar.st = xbw;
    const bool fused = (p.ph_hi - p.ph_lo) > 1;
    if (fused) bar = xcd_barrier_post((unsigned*)(ws0 + WS_CTL), xbw);
    int vb = bid;
    if (fused && threadIdx.x == 0) xbw[2] = xb_add((unsigned*)(ws0 + WS_CTL) + CW_XRANK + 64 * bar.x, 1u);
#define IN(k) (p.ph_lo <= (k) && (k) < p.ph_hi)
#define SEAM(k) do { if (fused && (k) + 1 < p.ph_hi) xcd_barrier(bar); } while (0)

    const bool n1_in_prologue = fused && p.ph_lo == 0 && p.ph_hi > 1;
    if (IN(0)) { const Params lp = load_params(); REP(0) phase_prologue(lp, lds);
        if (n1_in_prologue) { unsigned char* ws = ows_(lp.ws);
            if (otid() == 0) { unsigned* f = (unsigned*)(ws + WS_CTL) + CW_N1FLAG; XB_SPIN(xb_ld(f) < 16u, (unsigned*)(ws + WS_CTL)); __builtin_amdgcn_fence(__ATOMIC_ACQUIRE, "agent"); asm volatile("s_waitcnt vmcnt(0)" ::: "memory"); }
            __syncthreads();
            phase_norm(lp, 0, 0); }
        SEAM(0); }
    if (fused && p.ph_lo == 0) {
        if (threadIdx.x == 0) { unsigned pre = 0; for (unsigned j = 0; j < bar.x; ++j) pre += xb_ld((unsigned*)(ws0 + WS_CTL) + XB_XCNT(j)); xbw[3] = pre + xbw[2]; }
        __syncthreads();
        vb = (int)xbw[3]; if (vb >= nb) vb = bid;
    }
    for (int layer = 0; layer < 2; ++layer) {
        const int pb = 1 + layer * 11;
        if (IN(pb + 0)) { const Params lp = load_params(); unsigned char* ws = ows_(lp.ws); (void)ws; if (layer == 0 && !n1_in_prologue) { phase_norm(lp, 0, 0); SEAM(pb + 0); } }
        if (IN(pb + 1)) { const Params lp = load_params(); unsigned char* ws = ows_(lp.ws); (void)ws;
            EpiIn E{&lp, layer};
            REP(2) {
                { pg8::Gemm g{ws + WS_H, ws + WS_WIN, nullptr, HLD * 2, 2048, 2048}; SchedIn S{layer, vb}; EpiInP EP{&lp, layer};
                  pg8::gemm_phase<false>(lds, g, S, EP); __syncthreads(); }
                if (nb & 7) { for (int u = (bid + 128) % nb; u < 130; u += nb)
                    gemm_unit<256, 64, 8, 1, 3>((const bf16_t*)(ws + WS_H), HLD, nullptr, 0, u * 256, 1 << 30, (const bf16_t*)(ws + WS_WIN) + (size_t)layer * INWP * 1024, 1024, 2304, 16, lds, E); }
                else { const int per = nb >> 3, pos = vb % per;
                    if (pos >= per - NARROW_PER) { Ring rg{0, 0}; const int q = (vb / per) * NARROW_PER + pos - (per - NARROW_PER), nq = 8 * NARROW_PER;
                        for (int u = q; u < 130; u += nq)
                            gemm_unit<256, 64, 8, 1, 3>((const bf16_t*)(ws + WS_H), HLD, nullptr, 0, u * 256, 1 << 30, (const bf16_t*)(ws + WS_WIN) + (size_t)layer * INWP * 1024, 1024, 2304, 16, lds, E, &rg, u + nq < 130, (u + nq) * 256, 2304); } } }
            SEAM(pb + 1);
        }
        if (IN(pb + 2)) { const Params lp = load_params(); unsigned char* ws = ows_(lp.ws); (void)ws;
            const int mtq = layer == 0 ? 130 : 128;
            { EpiQup E{&lp, layer};
              Ring rg{0, 0};
              REP(31) for (int i = 0;; ++i) { int u; if (!xorder(mtq * 6, i, u, vb)) break; const int mt = u / 3, nt = u % 3; int un = 0; const bool hn = xorder(mtq * 6, i + 1, un, vb);
                  gemm_unit<128, 192, 4, 2, 3>((const bf16_t*)(ws + WS_ZC), 640, nullptr, 0, mt * 128, 1 << 30, (const bf16_t*)(ws + WS_WQ) + (size_t)layer * 576 * 384, 384, nt * 192, 6, lds, E, &rg, hn, (un / 3) * 128, (un % 3) * 192); } }
            { EpiKVup E{&lp, layer};
              Ring rg{0, 0};
              REP(31) for (int i = 0;; ++i) { int u; if (!xorder(130 * 6, i, u, vb)) break; const int mt = u / 6, nt = u % 6; int un = 0; const bool hn = xorder(130 * 6, i + 1, un, vb);
                  gemm_unit<256, 128, 4, 2, 3, EpiKVup, false, 1>((const bf16_t*)(ws + WS_ZC) + 384, 640, nullptr, 0, mt * 256, 1 << 30, (const bf16_t*)(ws + WS_WKV) + (size_t)layer * 768 * 256, 256, nt * 128, 4, lds, E, &rg, hn, (un / 6) * 256, (un % 6) * 128); } }
            { const int nun = 768 + (layer == 0 ? 12 : 0);
              REP(32) for (int u = bid; u < nun; u += nb) { if (u < 768) { const int bh = u >> 6, rg = u & 63; na_unit(lp, layer, bh / 6, bh % 6, rg, false, lds); } else { const int bh = u - 768; na_unit(lp, layer, bh / 6, bh % 6, 0, true, lds); } } }
            { const int nch = layer == 0 ? 260 : 256;
              REP(33) for (int u = bid; u < nch; u += nb) gmlp_unit(lp, layer, u, lds); }
            SEAM(pb + 2);
        }
        if (IN(pb + 3)) { const Params lp = load_params(); unsigned char* ws = ows_(lp.ws); (void)ws;
            const int nun = 768 + (layer == 0 ? 12 : 0);
            SideJob sj; sj.g = 0; sj.le = 0; sj.j = bid; sj.v0 = (f32x4){0.f, 0.f, 0.f, 0.f}; sj.v1 = sj.v0; while (sj.j >= 384) { sj.j -= 384; ++sj.le; }
            const bool xg = (nb == 256);
            REP(4) for (int it = 0;; ++it) { int u;
                if (xg) { if (it < 3) u = (vb >> 5) * 96 + (vb & 31) + 32 * it; else if (it == 3 && vb < nun - 768) u = 768 + vb; else break; }
                else { u = bid + it * nb; if (u >= nun) break; }
                if (rep_ != 0) { if (u < 768) { const int bh = u >> 6, qb = u & 63; mla_unit<PROBE_MODE>(lp, layer, bh / 6, bh % 6, (bh / 6) * SEQ + qb * 256, 0, 130, lds, sj); } continue; }
                if (u < 768) { const int bh = u >> 6, qb = u & 63; mla_unit<0>(lp, layer, bh / 6, bh % 6, (bh / 6) * SEQ + qb * 256, 0, 130, lds, sj); }
                else { const int bh = u - 768; mla_unit<0>(lp, layer, bh / 6, bh % 6, NLAT + (bh / 6) * 256, 128, 130, lds, sj); } }
            while (sj.le < 64) { const SjDesc d = sj_desc(lp, layer, sj.le, sj.j);
                xpose_item(d.s0, d.s1, d.ld, d.ld, nullptr, (bf16_t*)d.dst, d.ld_dst, d.k0, d.nt, d.mode, (LAS float*)lds, true); sj_advance(sj); }
            SEAM(pb + 3);
        }
        if (IN(pb + 4)) { const Params lp = load_params(); unsigned char* ws = ows_(lp.ws); (void)ws;
            EpiOut E{&lp, layer}; const int nun = 512 + (layer == 0 ? 64 : 0);
            { pg8::Gemm g{ws + WS_MIX, ws + WS_WOUT, nullptr, 2048, 2048, 2048}; SchedOut S{layer, vb}; EpiOutP EP{&lp, layer};
              pg8::gemm_phase<false>(lds, g, S, EP); __syncthreads(); }
            for (int v = bid; v < nun - 512; v += nb) { const int mt = v >> 3, nt = v & 7;
                gemm_unit<64, 128, 2, 4, 6>((const bf16_t*)(ws + WS_MIX), 1024, nullptr, 0, NLAT + mt * 64, 1 << 30, (const bf16_t*)(ws + WS_WOUTP) + (size_t)layer * 1024 * 1024, 1024, nt * 128, 16, lds, E); }
            SEAM(pb + 4);
        }
        if (IN(pb + 5)) { const Params lp = load_params(); unsigned char* ws = ows_(lp.ws); (void)ws;
            for (int u = bid; u < 256; u += nb) ffn_front_unit<128>(lp, layer, u * 128, lds);
            if (layer == 0) for (int u = (bid + 128) % nb; u < 8; u += nb) ffn_front_unit<64>(lp, layer, NLAT + u * 64, lds);
            SEAM(pb + 5);
        }
        if (IN(pb + 8)) { const Params lp = load_params(); unsigned char* ws = ows_(lp.ws); (void)ws; REP(9) phase_moe_gemm(lp, layer, 0, lds, vb); SEAM(pb + 8); }
        if (IN(pb + 9)) { const Params lp = load_params(); unsigned char* ws = ows_(lp.ws); (void)ws; REP(10) phase_moe_gemm(lp, layer, 1, lds, vb, fused && lp.ph_lo <= pb + 8); SEAM(pb + 9); }
        if (IN(pb + 10)) { const Params lp = load_params(); unsigned char* ws = ows_(lp.ws); (void)ws; phase_combine(lp, layer, lds, fused && lp.ph_lo <= pb + 8); SEAM(pb + 10); }
    }
#undef IN
#undef SEAM
}

extern "C" void kernel_launch(void* const* d_in, const int* in_sizes, int n_in, void* d_out, int out_size, void* d_ws, size_t ws_size, hipStream_t stream) {
    static int grid = 0;
    if (grid == 0) {
        if (n_in != 27 || ws_size < WS_END) { fprintf(stderr, "kernel_launch: need 27 inputs and %zu bytes of workspace (got %d, %zu)\n", (size_t)WS_END, n_in, ws_size); grid = -1; return; }
        int dev = 0, cus = 0, per_cu = 0;
        if (hipGetDevice(&dev) != hipSuccess || hipDeviceGetAttribute(&cus, hipDeviceAttributeMultiprocessorCount, dev) != hipSuccess) { grid = -1; return; }
        if (hipFuncSetAttribute((const void*)fwd, hipFuncAttributeMaxDynamicSharedMemorySize, LDS_BYTES) != hipSuccess) { fprintf(stderr, "kernel_launch: hipFuncSetAttribute failed\n"); grid = -1; return; }
        if (hipOccupancyMaxActiveBlocksPerMultiprocessor(&per_cu, (const void*)fwd, NTHREADS, LDS_BYTES) != hipSuccess || per_cu < 1) { fprintf(stderr, "kernel_launch: occupancy query says %d\n", per_cu); per_cu = 1; }
        (void)hipGetLastError();
        grid = cus;
    }
    if (grid < 0) return;
    (void)hipMemsetAsync((char*)d_ws + WS_CTL, 0, 65536, stream);
    Params p{};
    const float** pp = (const float**)&p;
    for (int i = 0; i < 27; ++i) pp[i] = (const float*)d_in[i];
    p.out = (float*)d_out; p.ws = (unsigned char*)d_ws;
#if N_LAUNCH_MODE == 1
    p.ph_lo = 0; p.ph_hi = NPHASE;
    hipLaunchKernelGGL(fwd, dim3(grid), dim3(NTHREADS), LDS_BYTES, stream, p);
#else
    for (int k = 0; k < NPHASE; ++k) {
        if (k == 12 || k == 7 || k == 8 || k == 18 || k == 19) continue;
        p.ph_lo = k; p.ph_hi = k + 1;
        hipLaunchKernelGGL(fwd, dim3(grid), dim3(NTHREADS), LDS_BYTES, stream, p);
    }
#endif
}
```
